# Optimizing an MI355X kernel written in HIP

```python
import math
import jax, jax.numpy as jnp
from jax import lax
import numpy as np

D_MODEL = 1024
BATCH = 32
SEQ = 2048
DEPTH = 1

MOBA_HEADS = 8
MOBA_HEAD_DIM = 64
MOBA_BLOCK = 256
MOBA_TOPK = 3
MOBA_Q_CHUNK = 16
RET_HEADS = 8
RET_QK_DIM = 64
RET_V_DIM = 128
RET_CHUNK = 128
D_FF = 4 * D_MODEL
ROPE_THETA = 10000.0
EPS = 1e-6

MOBA_W = MOBA_HEADS * MOBA_HEAD_DIM
RET_QK_W = RET_HEADS * RET_QK_DIM
RET_V_W = RET_HEADS * RET_V_DIM
IN_SPLITS = (MOBA_W, MOBA_W, MOBA_W, RET_QK_W, RET_QK_W, RET_V_W, RET_V_W, D_MODEL, D_MODEL)
IN_WIDTH = 3 * MOBA_W + 2 * RET_QK_W + 2 * RET_V_W + 2 * D_MODEL
N_ADA = 6

kernel_name = "hybrid_moba_retention_adaln_block"


def rms_norm(x, w):
    xf = x.astype(jnp.float32)
    y = xf * lax.rsqrt(jnp.mean(xf * xf, axis=-1, keepdims=True) + EPS)
    return (y * w.astype(jnp.float32)).astype(x.dtype)


def modulate(h, shift, scale):
    return h * (1 + scale) + shift


def rotary_tables(seq, inv_freq):
    pos = jnp.arange(seq, dtype=jnp.float32)
    ang = pos[:, None] * inv_freq[None, :]
    return jnp.cos(ang), jnp.sin(ang)


def apply_rotary(t, cos, sin):
    t1, t2 = jnp.split(t, 2, axis=-1)
    c = cos.astype(t.dtype)
    s = sin.astype(t.dtype)
    return jnp.concatenate([t1 * c - t2 * s, t1 * s + t2 * c], axis=-1)


def to_heads(t, n_heads):
    b, s, _ = t.shape
    return t.reshape(b, s, n_heads, -1).transpose(0, 2, 1, 3)


def from_heads(t):
    b, h, s, d = t.shape
    return t.transpose(0, 2, 1, 3).reshape(b, s, h * d)


def moba_attention(q, k, v):
    B, H, S, dh = q.shape
    T = MOBA_BLOCK
    Qc = MOBA_Q_CHUNK
    nb = -(-S // T)
    pad = nb * T - S
    kp = jnp.pad(k, ((0, 0), (0, 0), (0, pad), (0, 0)))
    vp = jnp.pad(v, ((0, 0), (0, 0), (0, pad), (0, 0)))
    kb = kp.reshape(B, H, nb, T, dh)
    vb = vp.reshape(B, H, nb, T, dh)
    scale = dh ** -0.5
    n_sel = min(MOBA_TOPK, nb - 1)
    nq = S // Qc
    q_c = q.reshape(B, H, nq, Qc, dh).transpose(2, 0, 1, 3, 4)

    if n_sel > 0:
        q_blk = jnp.arange(S) // T
        k_mean = jnp.mean(kb.astype(jnp.float32), axis=3)
        gate = jnp.einsum('bhsd,bhnd->bhsn', q.astype(jnp.float32), k_mean)
        past = jnp.arange(nb)[None, :] < q_blk[:, None]
        gate = jnp.where(past[None, None], gate, -jnp.inf)
        sel_score, sel_idx = lax.top_k(gate, n_sel)
        sel_valid = jnp.isfinite(sel_score)
        idx_c = sel_idx.reshape(B, H, nq, Qc, n_sel).transpose(2, 0, 1, 3, 4)
        valid_c = sel_valid.reshape(B, H, nq, Qc, n_sel).transpose(2, 0, 1, 3, 4)
    else:
        idx_c = jnp.zeros((nq, B, H, Qc, 1), jnp.int32)
        valid_c = jnp.zeros((nq, B, H, Qc, 1), bool)

    gather_blocks = jax.vmap(jax.vmap(lambda blocks, idx: blocks[idx]))

    def one_chunk(args):
        ci, q_i, idx_i, valid_i = args
        start = ci * Qc
        blk_start = (start // T) * T
        k_own = lax.dynamic_slice_in_dim(kp, blk_start, T, axis=2)
        v_own = lax.dynamic_slice_in_dim(vp, blk_start, T, axis=2)
        qpos = start + jnp.arange(Qc)
        kpos = blk_start + jnp.arange(T)
        s_own = jnp.einsum('bhqd,bhtd->bhqt', q_i, k_own).astype(jnp.float32) * scale
        s_own = jnp.where(kpos[None, :] <= qpos[:, None], s_own, -jnp.inf)
        if n_sel == 0:
            p_own = jax.nn.softmax(s_own, axis=-1).astype(v.dtype)
            return jnp.einsum('bhqt,bhtd->bhqd', p_own, v_own)
        k_sel = gather_blocks(kb, idx_i)
        v_sel = gather_blocks(vb, idx_i)
        s_sel = jnp.einsum('bhqd,bhqntd->bhqnt', q_i, k_sel).astype(jnp.float32) * scale
        s_sel = jnp.where(valid_i[..., None], s_sel, -jnp.inf)
        s_all = jnp.concatenate([s_sel.reshape(B, H, Qc, n_sel * T), s_own], axis=-1)
        p = jax.nn.softmax(s_all, axis=-1).astype(v.dtype)
        p_sel = p[..., :n_sel * T].reshape(B, H, Qc, n_sel, T)
        p_own = p[..., n_sel * T:]
        return (jnp.einsum('bhqnt,bhqntd->bhqd', p_sel, v_sel)
                + jnp.einsum('bhqt,bhtd->bhqd', p_own, v_own))

    out = lax.map(one_chunk, (jnp.arange(nq), q_c, idx_c, valid_c))
    return out.transpose(1, 2, 0, 3, 4).reshape(B, H, S, dh)


def retention_chunkwise(q, k, v):
    B, H, S, dk = q.shape
    dv = v.shape[-1]
    C = RET_CHUNK
    nc = S // C
    f32 = jnp.float32
    q = q.astype(f32)
    k = k.astype(f32) * (dk ** -0.5)
    v = v.astype(f32)
    log_g = jnp.log(1.0 - jnp.power(2.0, -5.0 - jnp.arange(H, dtype=f32)))
    qc = q.reshape(B, H, nc, C, dk)
    kc = k.reshape(B, H, nc, C, dk)
    vc = v.reshape(B, H, nc, C, dv)
    i = jnp.arange(C, dtype=f32)
    diff = i[:, None] - i[None, :]
    decay = jnp.where(diff >= 0, jnp.exp(jnp.maximum(diff, 0.0)[None] * log_g[:, None, None]), 0.0)
    scores = jnp.einsum('bhnid,bhnjd->bhnij', qc, kc) * decay[None, :, None]
    o_intra = jnp.einsum('bhnij,bhnje->bhnie', scores, vc)
    zeta = jnp.exp((C - 1 - i)[None, :] * log_g[:, None])
    kv = jnp.einsum('bhnjd,bhnje->bhnde', kc * zeta[None, :, None, :, None], vc)
    chunk_decay = jnp.exp(C * log_g)[None, :, None, None]

    def step(state, kv_n):
        return state * chunk_decay + kv_n, state

    _, r_prev = lax.scan(step, jnp.zeros((B, H, dk, dv), f32), kv.transpose(2, 0, 1, 3, 4))
    r_prev = r_prev.transpose(1, 2, 0, 3, 4)
    xi = jnp.exp((i + 1)[None, :] * log_g[:, None])
    o_cross = jnp.einsum('bhnid,bhnde->bhnie', qc, r_prev) * xi[None, :, None, :, None]
    return (o_intra + o_cross).reshape(B, H, S, dv)


def head_group_norm(o, gain):
    mu = jnp.mean(o, axis=-1, keepdims=True)
    var = jnp.mean(jnp.square(o - mu), axis=-1, keepdims=True)
    y = (o - mu) * lax.rsqrt(var + EPS)
    return from_heads(y) * gain.astype(jnp.float32)


def setup_inputs(seed: int = 0) -> dict:
    key = jax.random.key(seed)
    ks = jax.random.split(key, 16)
    f32 = jnp.float32

    def nrm(k, shape, fan_in):
        return jax.random.normal(k, shape, f32) * (fan_in ** -0.5)

    return {
        "x": jax.random.normal(ks[0], (BATCH, SEQ, D_MODEL), f32),
        "c": jax.random.normal(ks[1], (BATCH, D_MODEL), f32),
        "ln1_w": 1.0 + 0.02 * jax.random.normal(ks[2], (DEPTH, D_MODEL), f32),
        "ln2_w": 1.0 + 0.02 * jax.random.normal(ks[3], (DEPTH, D_MODEL), f32),
        "w_ada": nrm(ks[4], (DEPTH, D_MODEL, N_ADA * D_MODEL), D_MODEL),
        "b_ada": 0.02 * jax.random.normal(ks[5], (DEPTH, N_ADA * D_MODEL), f32),
        "w_in": nrm(ks[6], (DEPTH, D_MODEL, IN_WIDTH), D_MODEL),
        "ret_gn_w": 1.0 + 0.02 * jax.random.normal(ks[7], (DEPTH, RET_V_W), f32),
        "w_moba_o": nrm(ks[8], (DEPTH, MOBA_W, D_MODEL), MOBA_W),
        "w_ret_o": nrm(ks[9], (DEPTH, RET_V_W, D_MODEL), RET_V_W),
        "w_out": nrm(ks[10], (DEPTH, D_MODEL, D_MODEL), D_MODEL),
        "w_ff1": nrm(ks[11], (DEPTH, D_MODEL, D_FF), D_MODEL),
        "w_ff2": nrm(ks[12], (DEPTH, D_FF, D_MODEL), D_FF),
        "final_norm_w": 1.0 + 0.02 * jax.random.normal(ks[13], (D_MODEL,), f32),
    }


def reference(x, c, ln1_w, ln2_w, w_ada, b_ada, w_in, ret_gn_w, w_moba_o, w_ret_o,
              w_out, w_ff1, w_ff2, final_norm_w):
    S = x.shape[1]
    rope_inv = 1.0 / (ROPE_THETA ** (jnp.arange(0, MOBA_HEAD_DIM, 2, dtype=jnp.float32) / MOBA_HEAD_DIM))
    moba_cos, moba_sin = rotary_tables(S, rope_inv)
    ret_inv = 1.0 / (ROPE_THETA ** jnp.linspace(0.0, 1.0, RET_QK_DIM // 2, dtype=jnp.float32))
    ret_cos, ret_sin = rotary_tables(S, ret_inv)
    split_at = [int(v) for v in np.cumsum(IN_SPLITS)[:-1]]
    c_act = jax.nn.silu(c)

    for l in range(DEPTH):
        ada = (c_act @ w_ada[l] + b_ada[l])[:, None, :]
        sh1, sc1, g1, sh2, sc2, g2 = jnp.split(ada, N_ADA, axis=-1)

        h = modulate(rms_norm(x, ln1_w[l]), sh1, sc1)
        proj = h @ w_in[l]
        mq, mk, mv, rq, rk, rv, rg, ga, gr = jnp.split(proj, split_at, axis=-1)

        mq = apply_rotary(to_heads(mq, MOBA_HEADS), moba_cos, moba_sin)
        mk = apply_rotary(to_heads(mk, MOBA_HEADS), moba_cos, moba_sin)
        a_out = moba_attention(mq, mk, to_heads(mv, MOBA_HEADS))
        y_a = from_heads(a_out) @ w_moba_o[l]

        rq = apply_rotary(to_heads(rq, RET_HEADS), ret_cos, ret_sin)
        rk = apply_rotary(to_heads(rk, RET_HEADS), ret_cos, ret_sin)
        r_out = retention_chunkwise(rq, rk, to_heads(rv, RET_HEADS))
        r_out = head_group_norm(r_out, ret_gn_w[l]).astype(x.dtype)
        y_r = (jax.nn.silu(rg) * r_out) @ w_ret_o[l]

        merged = jax.nn.sigmoid(ga) * y_a + jax.nn.sigmoid(gr) * y_r
        x = x + g1 * (merged @ w_out[l])

        h2 = modulate(rms_norm(x, ln2_w[l]), sh2, sc2)
        x = x + g2 * (jnp.square(jax.nn.relu(h2 @ w_ff1[l])) @ w_ff2[l])

    return rms_norm(x, final_norm_w)
```

```cpp
#include <hip/hip_runtime.h>
#include <cstdio>
#include <cstdint>
#include <cmath>
namespace pg8 {
#define PG8_LAS __attribute__((address_space(3)))
typedef unsigned short bf16_t;
typedef short bf16x8 __attribute__((ext_vector_type(8)));
typedef float f32x4 __attribute__((ext_vector_type(4)));
typedef unsigned u32x4 __attribute__((ext_vector_type(4)));
constexpr int BM = 256, BK = 64, HALF = 128, HTB = HALF * BK * 2  , STAGE_BYTES = 8 * HTB, NXCD = 8, WGM = 8;

__host__ __device__ __forceinline__ int lds_byte(int r, int c) { const int st = (r >> 4) * 2 + (c >> 5), rr = r & 15, cc = c & 31, ob = rr * 64 + cc * 2; return st * 1024 + (ob ^ (((ob >> 9) & 1) << 5)); }
__host__ __device__ __forceinline__ void stage_rc(int b, int& R, int& C) { const int st = b / 1024, sb = b % 1024, swz = sb ^ (((sb >> 9) & 1) << 5); R = (st >> 1) * 16 + swz / 64; C = (st & 1) * 32 + (swz % 64) / 2; }
__host__ __device__ __forceinline__ int perm32(int rho) { const int n = rho >> 4, i = rho & 15; return 8 * (i >> 2) + 4 * n + (i & 3); }

struct Unit { int pm, pn; };
struct Gemm { const bf16_t* A; const bf16_t* Bt; int M, N, K; };

struct StaticOrder {
    int nM, nN, nwg, G, c;
    __host__ __device__ void init(int M, int N, int G_, int c_) { nM = M / BM; nN = N / BM; nwg = nM * nN; G = G_; c = c_; }
    __host__ __device__ bool next(int i, Unit& u) const {
        const long L = (long)i * G + c; if (L >= nwg) return false;
        int wgid = (int)L; { const int q = nwg / NXCD, r = nwg % NXCD, xcd = wgid % NXCD, off = wgid / NXCD; wgid = (xcd < r ? xcd * (q + 1) : r * (q + 1) + (xcd - r) * q) + off; }
        const int nig = WGM * nN, gid = wgid / nig, fm = gid * WGM, gsz = (nM - fm) < WGM ? (nM - fm) : WGM;
        u.pm = fm + ((wgid % nig) % gsz); u.pn = (wgid % nig) / gsz; return true;
    }
    __device__ __forceinline__ void a_ready(const Unit&) const {}
    __device__ __forceinline__ void done(const Unit&) const {}
};

__device__ __forceinline__ unsigned cvt_pk_bf16(float lo, float hi) { unsigned r; asm volatile("v_cvt_pk_bf16_f32 %0, %1, %2" : "=v"(r) : "v"(lo), "v"(hi)); return r; }
typedef float f32x2 __attribute__((ext_vector_type(2)));
typedef unsigned u32x2 __attribute__((ext_vector_type(2)));
__device__ __forceinline__ float sigm(float x) { return __builtin_amdgcn_rcpf(1.f + __builtin_amdgcn_exp2f(-1.4426950408889634f * x)); }
__device__ __forceinline__ float bf_lo(unsigned w) { return __builtin_bit_cast(float, w << 16); }
__device__ __forceinline__ float bf_hi(unsigned w) { return __builtin_bit_cast(float, w & 0xffff0000u); }
__device__ __forceinline__ u32x4 pack8(f32x4 a, f32x4 b) { u32x4 w; w.x = cvt_pk_bf16(a[0], a[1]); w.y = cvt_pk_bf16(a[2], a[3]); w.z = cvt_pk_bf16(b[0], b[1]); w.w = cvt_pk_bf16(b[2], b[3]); return w; }

struct EpiIn {
    static constexpr bool PERM = true, AFTER_DRAIN = false;
    bf16_t *MQ, *MK, *MV, *RQ, *RK, *RV, *RG, *SGA, *SGR; const float* rope_moba; const float* rope_ret; float* ksum; float qscale;
    __device__ __forceinline__ void operator()(const f32x4 (&acc)[2][2][4][2], const Unit& u, int wr, int wc, int fr, int fq) const {
        const int pn = u.pn; const int row0 = u.pm * BM + wr * 64 + fr;
        bf16_t* base; int ldc, colt, mode; float sc = 1.f; const float* tab = rope_moba;
        if (pn < 2)       { base = MQ;  ldc = 512;  colt = pn * 256;        mode = 1; sc = qscale; }
        else if (pn < 4)  { base = MK;  ldc = 512;  colt = (pn - 2) * 256;  mode = 1; }
        else if (pn < 6)  { base = MV;  ldc = 512;  colt = (pn - 4) * 256;  mode = 0; }
        else if (pn < 8)  { base = RQ;  ldc = 512;  colt = (pn - 6) * 256;  mode = 1; tab = rope_ret; }
        else if (pn < 10) { base = RK;  ldc = 512;  colt = (pn - 8) * 256;  mode = 1; tab = rope_ret; sc = 0.125f; }
        else if (pn < 14) { base = RV;  ldc = 1024; colt = (pn - 10) * 256; mode = 0; }
        else if (pn < 18) { base = RG;  ldc = 1024; colt = (pn - 14) * 256; mode = 2; }
        else if (pn < 22) { base = SGA; ldc = 1024; colt = (pn - 18) * 256; mode = 3; }
        else              { base = SGR; ldc = 1024; colt = (pn - 22) * 256; mode = 3; }
        const int col0 = colt + wc * 32 + 8 * fq;
        if (mode == 1) {
            const int g = 4 * (wc & 1) + fq; const bool isk = (pn == 2 || pn == 3);
            f32x4 ks[2][2];
#pragma unroll
            for (int bj = 0; bj < 2; ++bj)
#pragma unroll
                for (int n = 0; n < 2; ++n) ks[bj][n] = (f32x4){0.f, 0.f, 0.f, 0.f};
#pragma unroll
            for (int ai = 0; ai < 2; ++ai)
#pragma unroll
                for (int m = 0; m < 4; ++m) {
                    const int row = row0 + ai * HALF + m * 16; const int pos = row & 2047;
                    const f32x4 cs = *(const f32x4*)(tab + pos * 64 + 4 * g), sn = *(const f32x4*)(tab + pos * 64 + 32 + 4 * g);
                    bf16_t* rowp = base + (size_t)row * ldc + col0;
#pragma unroll
                    for (int bj = 0; bj < 2; ++bj) {
                        const f32x4 v0 = acc[ai][bj][m][0], v1 = acc[ai][bj][m][1];
                        const f32x4 o0 = (v0 * cs - v1 * sn) * sc, o1 = (v0 * sn + v1 * cs) * sc;
                        if (isk) { ks[bj][0] += o0; ks[bj][1] += o1; }
                        *(u32x4*)(rowp + bj * HALF) = pack8(o0, o1);
                    }
                }
            if (isk) {
#pragma unroll
                for (int bj = 0; bj < 2; ++bj)
#pragma unroll
                    for (int n = 0; n < 2; ++n)
#pragma unroll
                        for (int e = 0; e < 4; ++e) { float s = ks[bj][n][e]; s += __shfl_xor(s, 1); s += __shfl_xor(s, 2); s += __shfl_xor(s, 4); s += __shfl_xor(s, 8);
                            if (fr == 0) atomicAdd(ksum + (size_t)u.pm * 512 + col0 + bj * HALF + 4 * n + e, s); }
            }
        } else {
#pragma unroll
            for (int ai = 0; ai < 2; ++ai)
#pragma unroll
                for (int m = 0; m < 4; ++m) {
                    bf16_t* rowp = base + (size_t)(row0 + ai * HALF + m * 16) * ldc + col0;
#pragma unroll
                    for (int bj = 0; bj < 2; ++bj) {
                        f32x4 v0 = acc[ai][bj][m][0], v1 = acc[ai][bj][m][1];
                        if (mode >= 2) {
#pragma unroll
                            for (int e = 0; e < 4; ++e) { const float s0 = sigm(v0[e]), s1 = sigm(v1[e]); v0[e] = (mode == 2) ? v0[e] * s0 : s0; v1[e] = (mode == 2) ? v1[e] * s1 : s1; }
                        }
                        *(u32x4*)(rowp + bj * HALF) = pack8(v0, v1);
                    }
                }
        }
    }
};

template <bool ADD> struct EpiMerge {
    static constexpr bool PERM = true, AFTER_DRAIN = false;
    const bf16_t* gate; bf16_t* out;
    __device__ __forceinline__ void operator()(const f32x4 (&acc)[2][2][4][2], const Unit& u, int wr, int wc, int fr, int fq) const {
        const int row0 = u.pm * BM + wr * 64 + fr, col0 = u.pn * BM + wc * 32 + 8 * fq;
#pragma unroll
        for (int ai = 0; ai < 2; ++ai)
#pragma unroll
            for (int m = 0; m < 4; ++m) {
                const size_t off = (size_t)(row0 + ai * HALF + m * 16) * 1024 + col0;
#pragma unroll
                for (int bj = 0; bj < 2; ++bj) {
                    const u32x4 gw = *(const u32x4*)(gate + off + bj * HALF);
                    f32x4 v0 = acc[ai][bj][m][0], v1 = acc[ai][bj][m][1];
                    v0[0] *= bf_lo(gw.x); v0[1] *= bf_hi(gw.x); v0[2] *= bf_lo(gw.y); v0[3] *= bf_hi(gw.y);
                    v1[0] *= bf_lo(gw.z); v1[1] *= bf_hi(gw.z); v1[2] *= bf_lo(gw.w); v1[3] *= bf_hi(gw.w);
                    if (ADD) { const u32x4 pw = *(const u32x4*)(out + off + bj * HALF);
                        v0[0] += bf_lo(pw.x); v0[1] += bf_hi(pw.x); v0[2] += bf_lo(pw.y); v0[3] += bf_hi(pw.y);
                        v1[0] += bf_lo(pw.z); v1[1] += bf_hi(pw.z); v1[2] += bf_lo(pw.w); v1[3] += bf_hi(pw.w); }
                    *(u32x4*)(out + off + bj * HALF) = pack8(v0, v1);
                }
            }
    }
};

struct EpiRes {
    static constexpr bool PERM = false, AFTER_DRAIN = false;
    const float* xin; float* xo; const float* gvec  ; const float* lnw; const float* scv  ; bf16_t* A2; float* ss;
    __device__ __forceinline__ void operator()(const f32x4 (&acc)[2][2][4][2], const Unit& u, int wr, int wc, int fr, int fq) const {
        const int row0 = u.pm * BM + wr * 64 + fr, col0 = u.pn * BM + wc * 32 + 4 * fq; const int b = u.pm >> 3;
        f32x4 gv[2][2], we[2][2];
#pragma unroll
        for (int bj = 0; bj < 2; ++bj)
#pragma unroll
            for (int n = 0; n < 2; ++n) { const int c = col0 + bj * HALF + n * 16; gv[bj][n] = *(const f32x4*)(gvec + (size_t)b * 6144 + c);
                if (A2) { const f32x4 w = *(const f32x4*)(lnw + c), s = *(const f32x4*)(scv + (size_t)b * 6144 + c); we[bj][n] = w * (s + 1.0f); } else we[bj][n] = (f32x4){0.f, 0.f, 0.f, 0.f}; }
#pragma unroll
        for (int ai = 0; ai < 2; ++ai)
#pragma unroll
            for (int m = 0; m < 4; ++m) {
                const int row = row0 + ai * HALF + m * 16; const size_t off = (size_t)row * 1024 + col0; float q = 0.f;
#pragma unroll
                for (int bj = 0; bj < 2; ++bj)
#pragma unroll
                    for (int n = 0; n < 2; ++n) { const size_t o = off + bj * HALF + n * 16; const f32x4 xv = *(const f32x4*)(xin + o);
                        const f32x4 x1 = xv + gv[bj][n] * acc[ai][bj][m][n]; *(f32x4*)(xo + o) = x1; q += (x1[0] * x1[0] + x1[1] * x1[1]) + (x1[2] * x1[2] + x1[3] * x1[3]);
                        if (A2) { const f32x4 a = x1 * we[bj][n]; u32x2 w; w.x = cvt_pk_bf16(a[0], a[1]); w.y = cvt_pk_bf16(a[2], a[3]); *(u32x2*)(A2 + o) = w; } }
                q += __shfl_xor(q, 16); q += __shfl_xor(q, 32);
                if (fq == 0) atomicAdd(ss + row, q);
            }
    }
};

struct EpiFF1 {
    static constexpr bool PERM = true, AFTER_DRAIN = false;
    bf16_t* O; const float* c1; const float* ss; float eps;
    __device__ __forceinline__ void operator()(const f32x4 (&acc)[2][2][4][2], const Unit& u, int wr, int wc, int fr, int fq) const {
        const int row0 = u.pm * BM + wr * 64 + fr, col0 = u.pn * BM + wc * 32 + 8 * fq; const int b = u.pm >> 3;
        f32x4 cv[2][2];
#pragma unroll
        for (int bj = 0; bj < 2; ++bj)
#pragma unroll
            for (int n = 0; n < 2; ++n) cv[bj][n] = *(const f32x4*)(c1 + (size_t)b * 4096 + col0 + bj * HALF + 4 * n);
#pragma unroll
        for (int ai = 0; ai < 2; ++ai)
#pragma unroll
            for (int m = 0; m < 4; ++m) {
                const int row = row0 + ai * HALF + m * 16; const float rs = 1.0f / sqrtf(ss[row] * (1.0f / 1024.0f) + eps);
                bf16_t* rowp = O + (size_t)row * 4096 + col0;
#pragma unroll
                for (int bj = 0; bj < 2; ++bj) {
                    f32x4 v0 = acc[ai][bj][m][0] * rs + cv[bj][0], v1 = acc[ai][bj][m][1] * rs + cv[bj][1];
#pragma unroll
                    for (int e = 0; e < 4; ++e) { const float a = fmaxf(v0[e], 0.f), c = fmaxf(v1[e], 0.f); v0[e] = a * a; v1[e] = c * c; }
                    *(u32x4*)(rowp + bj * HALF) = pack8(v0, v1);
                }
            }
    }
};
template <class Epi, class Sched, bool ALIGN_EPI = false, bool SP2 = false>
__device__ __forceinline__ void gemm_phase(PG8_LAS unsigned char* lds, const Gemm g, const Sched& S, const Epi& E) {
    const int tid = threadIdx.x, wid = __builtin_amdgcn_readfirstlane(tid >> 6), lane = tid & 63, wr = wid >> 2, wc = wid & 3, fr = lane & 15, fq = lane >> 4;
    const int K = g.K, nt = K / BK;
    unsigned voffA[2], voffB[2];
#pragma unroll
    for (int i = 0; i < 2; ++i) { int R, C; stage_rc(tid * 16 + i * 8192, R, C); const int Rb = Epi::PERM ? ((R & ~31) + perm32(R & 31)) : R;
        voffA[i] = (unsigned)(R * K + C) * 2u; voffB[i] = (unsigned)(Rb * K + C) * 2u; }
    const size_t kstep = (size_t)(BK * 2);
    const size_t hstep = (size_t)HALF * K * 2;
    const size_t tstep = 2 * hstep;
    const unsigned ldsw = (unsigned)wid * 1024u;
    const int aoff = lds_byte(wr * 64 + fr, fq * 8), boff = lds_byte(wc * 32 + fr, fq * 8);
#define PG8_SA(b, h) (((b) * 2 + (h)) * HTB)
#define PG8_SB(b, h) ((4 + (b) * 2 + (h)) * HTB)
#define PG8_STAGE(bufoff, gbase, voff) do { _Pragma("unroll") for (int _i = 0; _i < 2; ++_i) \
        __builtin_amdgcn_global_load_lds((const unsigned*)((const char*)(gbase) + (voff)[_i]), (PG8_LAS unsigned*)(lds + (bufoff) + ldsw + _i * 8192), 16, 0, 0); } while (0)
#define PG8_LDA(dst, b, h) do { _Pragma("unroll") for (int m = 0; m < 4; ++m) _Pragma("unroll") for (int k = 0; k < 2; ++k) dst[m][k] = *(const PG8_LAS bf16x8*)(lds + PG8_SA(b, h) + aoff + m * 2048 + k * 1024); } while (0)
#define PG8_LDB(dst, b, h) do { _Pragma("unroll") for (int n = 0; n < 2; ++n) _Pragma("unroll") for (int k = 0; k < 2; ++k) dst[n][k] = *(const PG8_LAS bf16x8*)(lds + PG8_SB(b, h) + boff + n * 2048 + k * 1024); } while (0)
#define PG8_MMA(ai, bj, At, Bt) do { __builtin_amdgcn_s_setprio(1); _Pragma("unroll") for (int m = 0; m < 4; ++m) _Pragma("unroll") for (int n = 0; n < 2; ++n) _Pragma("unroll") for (int k = 0; k < 2; ++k) \
        acc[ai][bj][m][n] = __builtin_amdgcn_mfma_f32_16x16x32_bf16(Bt[n][k], At[m][k], acc[ai][bj][m][n], 0, 0, 0); __builtin_amdgcn_s_setprio(0); } while (0)
#define PG8_WAIT_V(n) asm volatile("s_waitcnt vmcnt(" #n ")" ::: "memory")
#define PG8_WAIT_L(n) asm volatile("s_waitcnt lgkmcnt(" #n ")" ::: "memory")
#define PG8_BAR __builtin_amdgcn_s_barrier()
#define PG8_SCHED __builtin_amdgcn_sched_barrier(0)
    Unit cur, nxt; int ui = 0;
    if (!S.next(0, cur)) return;
    f32x4 acc[2][2][4][2];
#pragma unroll
    for (int a = 0; a < 2; ++a)
#pragma unroll
        for (int b = 0; b < 2; ++b)
#pragma unroll
            for (int m = 0; m < 4; ++m)
#pragma unroll
                for (int n = 0; n < 2; ++n) acc[a][b][m][n] = (f32x4){0.f, 0.f, 0.f, 0.f};
    bf16x8 At[4][2], B0[2][2], B1[2][2];
    const char* cA = (const char*)g.A + (size_t)cur.pm * tstep; const char* cB = (const char*)g.Bt + (size_t)cur.pn * tstep;
    S.a_ready(cur);
    if constexpr (SP2) {
        PG8_STAGE(PG8_SB(0, 0), cB, voffB); PG8_STAGE(PG8_SB(0, 1), cB + hstep, voffB); PG8_STAGE(PG8_SA(0, 0), cA, voffA); PG8_STAGE(PG8_SA(0, 1), cA + hstep, voffA);
        if (wr == 1) PG8_BAR;
        PG8_WAIT_V(2); PG8_BAR;
        PG8_STAGE(PG8_SB(1, 0), cB + kstep, voffB); PG8_STAGE(PG8_SA(1, 0), cA + kstep, voffA); PG8_STAGE(PG8_SB(1, 1), cB + hstep + kstep, voffB);
        PG8_WAIT_V(6); PG8_BAR;
    } else {
        PG8_STAGE(PG8_SB(0, 0), cB, voffB); PG8_STAGE(PG8_SA(0, 0), cA, voffA); PG8_STAGE(PG8_SB(0, 1), cB + hstep, voffB); PG8_STAGE(PG8_SA(0, 1), cA + hstep, voffA);
        if (wr == 1) PG8_BAR;
        PG8_WAIT_V(4); PG8_BAR;
        PG8_STAGE(PG8_SB(1, 0), cB + kstep, voffB); PG8_STAGE(PG8_SA(1, 0), cA + kstep, voffA); PG8_STAGE(PG8_SB(1, 1), cB + hstep + kstep, voffB);
        PG8_WAIT_V(6); PG8_BAR;
    }
    for (;;) {
        const bool has_next = S.next(ui + 1, nxt);
        const char* nA = has_next ? (const char*)g.A + (size_t)nxt.pm * tstep : cA; const char* nB = has_next ? (const char*)g.Bt + (size_t)nxt.pn * tstep : cB;
        for (int t = 0; t < nt; t += 2) {
            const bool last = (t == nt - 2);
            const char* a1 = cA + (size_t)(t + 1) * kstep;
            const char* a2 = last ? nA : cA + (size_t)(t + 2) * kstep; const char* b2 = last ? nB : cB + (size_t)(t + 2) * kstep;
            const char* a3 = a2 + kstep; const char* b3 = b2 + kstep;
            if (last && has_next) S.a_ready(nxt);
            if constexpr (SP2) {
            PG8_LDB(B0, 0, 0); PG8_LDB(B1, 0, 1); PG8_SCHED; PG8_LDA(At, 0, 0); PG8_STAGE(PG8_SA(1, 1), a1 + hstep, voffA);
            PG8_WAIT_V(8); PG8_WAIT_L(0); PG8_BAR; PG8_MMA(0, 0, At, B0); PG8_MMA(0, 1, At, B1); PG8_BAR; PG8_SCHED;
            PG8_LDA(At, 0, 1); PG8_STAGE(PG8_SB(0, 0), b2, voffB); PG8_STAGE(PG8_SB(0, 1), b2 + hstep, voffB); PG8_STAGE(PG8_SA(0, 0), a2, voffA);
            PG8_WAIT_V(8); PG8_WAIT_L(0); PG8_BAR; PG8_MMA(1, 0, At, B0); PG8_MMA(1, 1, At, B1); PG8_BAR; PG8_SCHED;
            PG8_LDB(B0, 1, 0); PG8_LDB(B1, 1, 1); PG8_SCHED; PG8_LDA(At, 1, 0); PG8_STAGE(PG8_SA(0, 1), a2 + hstep, voffA);
            PG8_WAIT_V(8); PG8_WAIT_L(0); PG8_BAR; PG8_MMA(0, 0, At, B0); PG8_MMA(0, 1, At, B1); PG8_BAR; PG8_SCHED;
            PG8_LDA(At, 1, 1); PG8_STAGE(PG8_SB(1, 0), b3, voffB); PG8_STAGE(PG8_SB(1, 1), b3 + hstep, voffB); PG8_STAGE(PG8_SA(1, 0), a3, voffA);
            PG8_WAIT_V(8); PG8_WAIT_L(0); PG8_BAR; PG8_MMA(1, 0, At, B0); PG8_MMA(1, 1, At, B1); PG8_BAR; PG8_SCHED;
            } else {
            PG8_LDB(B0, 0, 0); PG8_SCHED; PG8_LDA(At, 0, 0); PG8_STAGE(PG8_SA(1, 1), a1 + hstep, voffA);
            PG8_WAIT_L(8); PG8_BAR; PG8_WAIT_L(0); PG8_MMA(0, 0, At, B0); PG8_BAR; PG8_SCHED;
            PG8_LDB(B1, 0, 1); PG8_STAGE(PG8_SB(0, 0), b2, voffB);
            PG8_BAR; PG8_WAIT_L(0); PG8_MMA(0, 1, At, B1); PG8_BAR;
            PG8_LDA(At, 0, 1); PG8_STAGE(PG8_SA(0, 0), a2, voffA);
            PG8_BAR; PG8_WAIT_L(0); PG8_MMA(1, 0, At, B0); PG8_BAR; PG8_SCHED;
            PG8_STAGE(PG8_SB(0, 1), b2 + hstep, voffB);
            PG8_WAIT_V(6); PG8_BAR; PG8_MMA(1, 1, At, B1); PG8_BAR;
            PG8_LDB(B0, 1, 0); PG8_SCHED; PG8_LDA(At, 1, 0); PG8_STAGE(PG8_SA(0, 1), a2 + hstep, voffA);
            PG8_WAIT_L(8); PG8_BAR; PG8_WAIT_L(0); PG8_MMA(0, 0, At, B0); PG8_BAR; PG8_SCHED;
            PG8_LDB(B1, 1, 1); PG8_STAGE(PG8_SB(1, 0), b3, voffB);
            PG8_BAR; PG8_WAIT_L(0); PG8_MMA(0, 1, At, B1); PG8_BAR;
            PG8_LDA(At, 1, 1); PG8_STAGE(PG8_SA(1, 0), a3, voffA);
            PG8_BAR; PG8_WAIT_L(0); PG8_MMA(1, 0, At, B0); PG8_BAR; PG8_SCHED;
            PG8_STAGE(PG8_SB(1, 1), b3 + hstep, voffB);
            PG8_WAIT_V(6); PG8_BAR; PG8_MMA(1, 1, At, B1); PG8_BAR;
            }
        }
        if constexpr (ALIGN_EPI) { if (wr == 0) PG8_BAR; }
        if constexpr (!Epi::AFTER_DRAIN) { E(acc, cur, wr, wc, fr, fq); S.done(cur); }
        if (!has_next) break;
#pragma unroll
        for (int a = 0; a < 2; ++a)
#pragma unroll
            for (int b = 0; b < 2; ++b)
#pragma unroll
                for (int m = 0; m < 4; ++m)
#pragma unroll
                    for (int n = 0; n < 2; ++n) acc[a][b][m][n] = (f32x4){0.f, 0.f, 0.f, 0.f};
        cur = nxt; cA = nA; cB = nB; ++ui;
        if constexpr (ALIGN_EPI) { if (wr == 1) PG8_BAR; }
    }
    PG8_WAIT_V(0);
    if constexpr (!ALIGN_EPI) { if (wr == 0) PG8_BAR; }
    PG8_BAR;
    if constexpr (Epi::AFTER_DRAIN) { E.fused(acc, cur, wr, wc, fr, fq, lds, wid, lane); S.done(cur); }
#undef PG8_SA
#undef PG8_SB
#undef PG8_STAGE
#undef PG8_LDA
#undef PG8_LDB
#undef PG8_MMA
#undef PG8_WAIT_V
#undef PG8_WAIT_L
#undef PG8_BAR
#undef PG8_SCHED
}
}
#define GAS __attribute__((address_space(1)))
#define LAS __attribute__((address_space(3)))
typedef unsigned short bf16;
typedef unsigned v4u __attribute__((ext_vector_type(4)));
typedef float f32x4 __attribute__((ext_vector_type(4)));
typedef short bf16x8 __attribute__((ext_vector_type(8)));
typedef GAS unsigned gu32;
typedef GAS unsigned long long gu64;
#define RLX_AGENT __ATOMIC_RELAXED, __HIP_MEMORY_SCOPE_AGENT
#define LDS_WAIT() asm volatile("s_waitcnt lgkmcnt(0)" ::: "memory")
#define VM_WAIT() asm volatile("s_waitcnt vmcnt(0)" ::: "memory")
__device__ __forceinline__ unsigned long long rt() { return __builtin_amdgcn_s_memrealtime(); }
__device__ __forceinline__ unsigned f2bf(float f) { unsigned u = __builtin_bit_cast(unsigned, f); return (u + 0x7fffu + ((u >> 16) & 1u)) >> 16; }
__device__ __forceinline__ unsigned pk2(float lo, float hi) { return f2bf(lo) | (f2bf(hi) << 16); }

#define XB_TMO      128
#define XB_XCNT(j)  (256  + 64 * (j))
#define XB_XSUB(j)  (1280 + 64 * (j))
#define XB_XGEN(j)  (2304 + 64 * (j))
#define XB_TOP      3328
#define XB_TOPGEN   3392
#define XCD_BAR_WORDS 3456
#define XB_SPIN_CAP (1u << 18)

__device__ __forceinline__ unsigned xb_ld(unsigned* p)              { return __hip_atomic_load(p, __ATOMIC_RELAXED, __HIP_MEMORY_SCOPE_AGENT); }
__device__ __forceinline__ unsigned xb_add(unsigned* p, unsigned v) { return __hip_atomic_fetch_add(p, v, __ATOMIC_RELAXED, __HIP_MEMORY_SCOPE_AGENT); }
__device__ __forceinline__ unsigned xb_xcc_id() { return (unsigned)__builtin_amdgcn_s_getreg((3 << 11) | 20) & 0xFu; }
#define XB_SPIN(cond, bar) do { unsigned _sp = 0; while (cond) { __builtin_amdgcn_s_sleep(1); \
    if ((++_sp & 255u) == 0u) { if (xb_ld(&(bar)[XB_TMO])) break; if (_sp > XB_SPIN_CAP) { atomicAdd(&(bar)[XB_TMO], 1u); break; } } } } while (0)

struct XcdBarrier {
    unsigned* bar; unsigned x;
    volatile LAS unsigned* st;
};

__device__ __forceinline__ XcdBarrier xcd_barrier_post(unsigned* bar, volatile LAS unsigned* st) {
    XcdBarrier b; b.bar = bar; b.x = xb_xcc_id(); b.st = st;
    if (threadIdx.x == 0) (void)xb_add(&bar[XB_XCNT(b.x)], 1u);
    return b;
}
__device__ __forceinline__ void xcd_barrier_complete(unsigned* bar, unsigned x, unsigned& nloc, unsigned& nx) {
    const unsigned G = gridDim.x * gridDim.y * gridDim.z;
    unsigned sum, cnt, mine, sp = 0u;
    for (;;) {
        sum = 0u; cnt = 0u; mine = 0u;
#pragma unroll
        for (unsigned j = 0; j < 16; ++j) { const unsigned c = xb_ld(&bar[XB_XCNT(j)]); sum += c; cnt += (c > 0u) ? 1u : 0u; mine = (j == x) ? c : mine; }
        if (sum == G) break;
        __builtin_amdgcn_s_sleep(1);
        if ((++sp & 255u) == 0u) { if (xb_ld(&bar[XB_TMO])) break; if (sp > XB_SPIN_CAP) { atomicAdd(&bar[XB_TMO], 1u); break; } }
    }
    nloc = mine > 0u ? mine : 1u; nx = cnt > 0u ? cnt : 1u;
}

__device__ __forceinline__ void xcd_barrier(const XcdBarrier& b) {
    asm volatile("s_waitcnt vmcnt(0)" ::: "memory");
    __syncthreads();
    if (threadIdx.x == 0) {
        unsigned* bar = b.bar;
        __builtin_amdgcn_s_waitcnt(0);
        unsigned nloc = b.st[0], nx = b.st[1];
        if (nloc == 0u) { xcd_barrier_complete(bar, b.x, nloc, nx); b.st[0] = nloc; b.st[1] = nx; }
        const unsigned old = xb_add(&bar[XB_XSUB(b.x)], 1u);
        const unsigned gen = old / nloc;
        if (old + 1u == (gen + 1u) * nloc) {
            __builtin_amdgcn_fence(__ATOMIC_RELEASE, "agent");
            asm volatile("s_waitcnt vmcnt(0)" ::: "memory");
            const unsigned og = xb_add(&bar[XB_TOP], 1u);
            const unsigned tg = og / nx;
            if (og + 1u == (tg + 1u) * nx) xb_add(&bar[XB_TOPGEN], 1u);
            else XB_SPIN(xb_ld(&bar[XB_TOPGEN]) == tg, bar);
            __builtin_amdgcn_fence(__ATOMIC_ACQUIRE, "agent");
            xb_add(&bar[XB_XGEN(b.x)], 1u);
            asm volatile("s_waitcnt vmcnt(0)" ::: "memory");
        } else {
            XB_SPIN(xb_ld(&bar[XB_XGEN(b.x)]) == gen, bar);
            __builtin_amdgcn_fence(__ATOMIC_ACQUIRE, "agent");
            asm volatile("s_waitcnt vmcnt(0)" ::: "memory");
        }
    }
    __syncthreads();
}

constexpr int NWAVES = 8;
constexpr int BATCH = 32, SEQ = 2048, D = 1024, FF = 4096, NIN = 6656, NADA = 6144;
constexpr int M = BATCH * SEQ;
constexpr float EPSN = 1e-6f;
constexpr float QSCALE = 0.125f * 1.4426950408889634f;
constexpr size_t KiB = 1024, MiB = 1u << 20;
constexpr size_t WS_CTL = 0;
constexpr size_t WS_ADA = 64 * KiB;
constexpr size_t WS_C1 = 832 * KiB;
constexpr size_t WS_KSUM = 1344 * KiB;
constexpr size_t WS_SS1 = 1856 * KiB;
constexpr size_t WS_SS2 = 2112 * KiB;
constexpr size_t ZERO_BYTES = 2560 * KiB;
constexpr size_t WS_ROPE = 3 * MiB;
constexpr size_t WS_WIN = 8 * MiB, WS_WMO = 21 * MiB, WS_WRO = 22 * MiB, WS_WOUT = 24 * MiB, WS_W1 = 26 * MiB, WS_W2 = 34 * MiB;
constexpr size_t WS_H = 48 * MiB;
constexpr size_t WS_MQ = 176 * MiB, WS_MK = 240 * MiB, WS_MV = 304 * MiB, WS_RQ = 368 * MiB, WS_RK = 432 * MiB;
constexpr size_t WS_RV = 496 * MiB, WS_RG = 624 * MiB, WS_SGA = 752 * MiB, WS_SGR = 880 * MiB;
constexpr size_t WS_A2 = 240 * MiB;
constexpr size_t WS_ACT = 496 * MiB;
constexpr size_t WS_END = 1008 * MiB;
constexpr int CW_BAR = 4096;
constexpr int RING_OFF = 0, RING_BYTES = 131072;
constexpr int LDSCTL_OFF = RING_BYTES, MISC_OFF = LDSCTL_OFF + 320;
constexpr int LDS_BYTES = 147456;

struct Frame {
    LAS unsigned char* lds;
    volatile LAS unsigned* MISC;
    int tid, lane, wave, vcu, G;
};

__device__ __forceinline__ float wave_sum(float v) {
#pragma unroll
    for (int o = 1; o < 64; o <<= 1) v += __shfl_xor(v, o);
    return v;
}
__device__ __forceinline__ int win_dst_row(int n) {
    const bool qk = (n < 1024) || (n >= 1536 && n < 2560);
    if (!qk) return n;
    const int d = n & 63, s = d >> 5, i = d & 31;
    return (n & ~63) + 8 * (i >> 2) + 4 * s + (i & 3);
}
template <bool PERMUTE>
__device__ __forceinline__ void p0_transpose_item(const float* W, int K, int N, bf16* WT, LAS float* scr, int item, int lane) {
    const int nblk = N / 32, kb = item / nblk, nb = item % nblk, k0 = 64 * kb, n0 = 32 * nb;
#pragma unroll 8
    for (int i = 0; i < 32; ++i) { const int kk = 2 * i + (lane >> 5); scr[kk * 33 + (lane & 31)] = W[(size_t)(k0 + kk) * N + n0 + (lane & 31)]; }
    LDS_WAIT(); asm volatile("" ::: "memory");
    const int c = lane & 7;
#pragma unroll
    for (int j = 0; j < 4; ++j) { const int n = (lane >> 3) + 8 * j; const LAS float* s = scr + (8 * c) * 33 + n;
        v4u o; o.x = pk2(s[0 * 33], s[1 * 33]); o.y = pk2(s[2 * 33], s[3 * 33]); o.z = pk2(s[4 * 33], s[5 * 33]); o.w = pk2(s[6 * 33], s[7 * 33]);
        const int drow = PERMUTE ? win_dst_row(n0 + n) : (n0 + n);
        *(GAS v4u*)(WT + (size_t)drow * K + k0 + 8 * c) = o; }
    LDS_WAIT(); asm volatile("" ::: "memory");
}
typedef float f32x16 __attribute__((ext_vector_type(16)));
template <bool SILU>
__device__ __forceinline__ void gemv32_item(const float* in, int ldin, const float* W, int N, const float* bias, float* out, int ldout, int k0, int KS, int n0, int lane) {
    const int r = lane & 31, hh = lane >> 5;
    f32x16 acc;
#pragma unroll
    for (int i = 0; i < 16; ++i) acc[i] = 0.f;
#pragma unroll 8
    for (int kk = 0; kk < KS; kk += 2) {
        float a = in[(size_t)r * ldin + k0 + kk + hh]; if (SILU) a = a / (1.0f + __expf(-a));
        const float w = W[(size_t)(k0 + kk + hh) * N + n0 + r];
        acc = __builtin_amdgcn_mfma_f32_32x32x2f32(a, w, acc, 0, 0, 0);
    }
    const float bv = (bias && k0 == 0) ? bias[n0 + r] : 0.f;
#pragma unroll
    for (int i = 0; i < 16; ++i) { const int brow = (i & 3) + 8 * (i >> 2) + 4 * hh; atomicAdd(out + (size_t)brow * ldout + n0 + r, acc[i] + bv); }
}
__device__ __forceinline__ void sincos_d(double ang, float& sn, float& cs) {
    const double k = rint(ang * 0.63661977236758134308);
    const double t = (ang - k * 1.57079632679489655800) - k * 6.12323399573676603587e-17, t2 = t * t;
    double s = -1.0 / 6227020800.0; s = s * t2 + 1.0 / 39916800.0; s = s * t2 - 1.0 / 362880.0; s = s * t2 + 1.0 / 5040.0; s = s * t2 - 1.0 / 120.0; s = s * t2 + 1.0 / 6.0; s = t - t * t2 * s;
    double c = 1.0 / 479001600.0; c = c * t2 - 1.0 / 3628800.0; c = c * t2 + 1.0 / 40320.0; c = c * t2 - 1.0 / 720.0; c = c * t2 + 1.0 / 24.0; c = c * t2 - 0.5; c = 1.0 + t2 * c;
    const int q = (int)((long long)k & 3);
    const double ss = (q == 0) ? s : (q == 1) ? c : (q == 2) ? -s : -c;
    const double cc = (q == 0) ? c : (q == 1) ? -s : (q == 2) ? -c : s;
    sn = (float)ss; cs = (float)cc;
}

struct Ptrs {
    const float *x, *c, *ln1w, *ln2w, *wada, *bada, *win, *gnw, *wmo, *wro, *wout, *wff1, *wff2, *fnw;
    float* out; unsigned char* ws;
};

__device__ __forceinline__ void phase0(Frame& F, const Ptrs& P) {
    const int gw = F.vcu * NWAVES + F.wave, NGW = F.G * NWAVES;
    for (int gt = gw * 64 + F.lane; gt < 2 * 2048 * 32; gt += NGW * 64) {
        const int tb = gt >> 16, pos = (gt >> 5) & 2047, f = gt & 31;
        const double e = (tb == 0) ? (double)f * (1.0 / 32.0) : (double)f * (1.0 / 31.0);
        const double inv = exp2(-e * 13.28771237954945);
        float sn, cs; sincos_d((double)pos * inv, sn, cs);
        float* tab = (float*)(P.ws + WS_ROPE) + (size_t)tb * 2048 * 64 + pos * 64;
        tab[f] = cs; tab[32 + f] = sn;
    }
    for (int it = gw; it < 8 * 192; it += NGW) { const int ks = it / 192, cg = it % 192;
        gemv32_item<true>(P.c, D, P.wada, NADA, P.bada, (float*)(P.ws + WS_ADA), NADA, ks * 128, 128, cg * 32, F.lane); }
    LAS float* scr = (LAS float*)(F.lds + RING_OFF + F.wave * 16384);
    constexpr int I_IN = (D / 64) * (NIN / 32), I_MO = (512 / 64) * (D / 32), I_RO = (D / 64) * (D / 32), I_OUT = I_RO, I_1 = (D / 64) * (FF / 32), I_2 = (FF / 64) * (D / 32);
    constexpr int NITEMS = I_IN + I_MO + I_RO + I_OUT + I_1 + I_2;
    for (int it = gw; it < NITEMS; it += NGW) {
        int r = it;
        if (r < I_IN) { p0_transpose_item<true>(P.win, D, NIN, (bf16*)(P.ws + WS_WIN), scr, r, F.lane); continue; } r -= I_IN;
        if (r < I_MO) { p0_transpose_item<false>(P.wmo, 512, D, (bf16*)(P.ws + WS_WMO), scr, r, F.lane); continue; } r -= I_MO;
        if (r < I_RO) { p0_transpose_item<false>(P.wro, D, D, (bf16*)(P.ws + WS_WRO), scr, r, F.lane); continue; } r -= I_RO;
        if (r < I_OUT) { p0_transpose_item<false>(P.wout, D, D, (bf16*)(P.ws + WS_WOUT), scr, r, F.lane); continue; } r -= I_OUT;
        if (r < I_1) { p0_transpose_item<false>(P.wff1, D, FF, (bf16*)(P.ws + WS_W1), scr, r, F.lane); continue; } r -= I_1;
        p0_transpose_item<false>(P.wff2, FF, D, (bf16*)(P.ws + WS_W2), scr, r, F.lane);
    }
}
__device__ __forceinline__ void phase1(Frame& F, const Ptrs& P) {
    const int gw = F.vcu * NWAVES + F.wave, NGW = F.G * NWAVES;
    const float* ada = (const float*)(P.ws + WS_ADA);
    for (int it = gw; it < 8 * 128; it += NGW) { const int ks = it / 128, cg = it % 128;
        gemv32_item<false>(ada + 3 * D, NADA, P.wff1, FF, nullptr, (float*)(P.ws + WS_C1), FF, ks * 128, 128, cg * 32, F.lane); }
    bf16* H = (bf16*)(P.ws + WS_H);
    for (int r0 = gw * 32; r0 < M; r0 += NGW * 32) {
        const int b = r0 >> 11;
        f32x4 we[4], sh[4];
#pragma unroll
        for (int j = 0; j < 4; ++j) { const int c = 4 * F.lane + 256 * j; const f32x4 w = *(const f32x4*)(P.ln1w + c), s = *(const f32x4*)(ada + (size_t)b * NADA + D + c);
            we[j] = w * (s + 1.0f); sh[j] = *(const f32x4*)(ada + (size_t)b * NADA + c); }
        for (int rr = 0; rr < 32; rr += 2) {
            f32x4 v[2][4]; float s2[2] = {0.f, 0.f};
#pragma unroll
            for (int q = 0; q < 2; ++q) { const GAS f32x4* xr = (const GAS f32x4*)(P.x + (size_t)(r0 + rr + q) * D) + F.lane;
#pragma unroll
                for (int j = 0; j < 4; ++j) v[q][j] = xr[64 * j]; }
#pragma unroll
            for (int q = 0; q < 2; ++q) {
#pragma unroll
                for (int j = 0; j < 4; ++j) s2[q] += (v[q][j].x * v[q][j].x + v[q][j].y * v[q][j].y) + (v[q][j].z * v[q][j].z + v[q][j].w * v[q][j].w);
                const float rstd = 1.0f / sqrtf(wave_sum(s2[q]) * (1.0f / D) + EPSN);
                GAS unsigned long long* o8 = (GAS unsigned long long*)(H + (size_t)(r0 + rr + q) * D) + F.lane;
#pragma unroll
                for (int j = 0; j < 4; ++j) { const f32x4 y = v[q][j] * rstd * we[j] + sh[j];
                    o8[64 * j] = (unsigned long long)pk2(y.x, y.y) | ((unsigned long long)pk2(y.z, y.w) << 32); }
            }
        }
    }
}
__device__ __forceinline__ void phase8(Frame& F, const Ptrs& P) {
    const int gw = F.vcu * NWAVES + F.wave, NGW = F.G * NWAVES;
    const float* ss2 = (const float*)(P.ws + WS_SS2);
    f32x4 fw[4];
#pragma unroll
    for (int j = 0; j < 4; ++j) fw[j] = *(const f32x4*)(P.fnw + 4 * F.lane + 256 * j);
    for (int r0 = gw * 32; r0 < M; r0 += NGW * 32) {
        for (int rr = 0; rr < 32; rr += 2) {
            f32x4 v[2][4];
#pragma unroll
            for (int q = 0; q < 2; ++q) { const GAS f32x4* xr = (const GAS f32x4*)(P.out + (size_t)(r0 + rr + q) * D) + F.lane;
#pragma unroll
                for (int j = 0; j < 4; ++j) v[q][j] = xr[64 * j]; }
#pragma unroll
            for (int q = 0; q < 2; ++q) { const float rstd = 1.0f / sqrtf(ss2[r0 + rr + q] * (1.0f / D) + EPSN);
                GAS f32x4* xo = (GAS f32x4*)(P.out + (size_t)(r0 + rr + q) * D) + F.lane;
#pragma unroll
                for (int j = 0; j < 4; ++j) xo[64 * j] = v[q][j] * rstd * fw[j]; }
        }
    }
}

__device__ __forceinline__ void unpack8(const v4u w, float* f) {
    f[0] = __builtin_bit_cast(float, w.x << 16); f[1] = __builtin_bit_cast(float, w.x & 0xffff0000u); f[2] = __builtin_bit_cast(float, w.y << 16); f[3] = __builtin_bit_cast(float, w.y & 0xffff0000u);
    f[4] = __builtin_bit_cast(float, w.z << 16); f[5] = __builtin_bit_cast(float, w.z & 0xffff0000u); f[6] = __builtin_bit_cast(float, w.w << 16); f[7] = __builtin_bit_cast(float, w.w & 0xffff0000u);
}
__device__ __forceinline__ unsigned moba_select(const float (&g)[7], int qb) {
    unsigned sel = 0;
#pragma unroll
    for (int j = 0; j < 7; ++j) { int cnt = 0;
#pragma unroll
        for (int k = 0; k < 7; ++k) if (k != j) cnt += (k < qb) && ((g[k] > g[j]) || (g[k] == g[j] && k < j));
        if (j < qb && cnt < 3) sel |= 1u << j; }
    return sel;
}
__device__ void naive_moba(Frame& F, const Ptrs& P) {
    const bf16* MQ = (const bf16*)(P.ws + WS_MQ); const bf16* MK = (const bf16*)(P.ws + WS_MK); const bf16* MV = (const bf16*)(P.ws + WS_MV); bf16* O = (bf16*)(P.ws + WS_MQ);
    const float* ksum = (const float*)(P.ws + WS_KSUM);
    const int gt0 = (F.vcu * NWAVES + F.wave) * 64 + F.lane, NT = F.G * NWAVES * 64;
    for (int idx = gt0; idx < BATCH * 8 * SEQ; idx += NT) {
        const int s = idx & 2047, bh = idx >> 11, b = bh >> 3, h = bh & 7, qb = s >> 8; const size_t row = (size_t)b * SEQ + s;
        float q[64];
#pragma unroll
        for (int i = 0; i < 8; ++i) unpack8(*(const v4u*)(MQ + row * 512 + h * 64 + 8 * i), q + 8 * i);
        float g[7];
#pragma unroll
        for (int j = 0; j < 7; ++j) { float a = 0.f; if (j < qb) { const float* kp = ksum + (size_t)(b * 8 + j) * 512 + h * 64;
#pragma unroll
                for (int d = 0; d < 64; ++d) a += q[d] * kp[d]; } g[j] = a; }
        const unsigned sel = moba_select(g, qb);
        float mx = -INFINITY, l = 0.f; float o[64];
#pragma unroll
        for (int d = 0; d < 64; ++d) o[d] = 0.f;
        for (int it = 0; it <= qb; ++it) {
            const int j = (it == 0) ? qb : it - 1; if (it > 0 && !((sel >> j) & 1u)) continue;
            const int nk = (it == 0) ? (s & 255) + 1 : 256;
#pragma unroll 1
            for (int k = 0; k < nk; ++k) {
                const size_t kr = (size_t)b * SEQ + j * 256 + k; float a = 0.f;
#pragma unroll
                for (int c = 0; c < 8; ++c) { float kf[8]; unpack8(*(const v4u*)(MK + kr * 512 + h * 64 + 8 * c), kf);
#pragma unroll
                    for (int d = 0; d < 8; ++d) a += q[8 * c + d] * kf[d]; }
                if (a > mx) { const float f = __builtin_amdgcn_exp2f(mx - a); mx = a; l *= f;
#pragma unroll
                    for (int d = 0; d < 64; ++d) o[d] *= f; }
                const float p = __builtin_amdgcn_exp2f(a - mx); l += p;
#pragma unroll
                for (int c = 0; c < 8; ++c) { float vf[8]; unpack8(*(const v4u*)(MV + kr * 512 + h * 64 + 8 * c), vf);
#pragma unroll
                    for (int d = 0; d < 8; ++d) o[8 * c + d] += p * vf[d]; }
            }
        }
        const float rl = 1.0f / l;
#pragma unroll
        for (int i = 0; i < 8; ++i) { v4u w; w.x = pk2(o[8 * i] * rl, o[8 * i + 1] * rl); w.y = pk2(o[8 * i + 2] * rl, o[8 * i + 3] * rl); w.z = pk2(o[8 * i + 4] * rl, o[8 * i + 5] * rl); w.w = pk2(o[8 * i + 6] * rl, o[8 * i + 7] * rl);
            *(v4u*)(O + row * 512 + h * 64 + 8 * i) = w; }
    }
}
__device__ void naive_ret(Frame& F, const Ptrs& P) {
    const bf16* RQ = (const bf16*)(P.ws + WS_RQ); const bf16* RK = (const bf16*)(P.ws + WS_RK); const bf16* RV = (const bf16*)(P.ws + WS_RV); bf16* RG = (bf16*)(P.ws + WS_RG);
    LAS float* Qs = (LAS float*)(F.lds + RING_OFF); LAS float* Ks = Qs + 1024; LAS float* Vs = Ks + 1024; LAS float* Pt = Vs + 2048;
    const int t = F.tid, e = t & 127, grp = t >> 7, d0 = grp * 16;
    for (int u = F.vcu; u < BATCH * 8; u += F.G) {
        const int b = u >> 3, h = u & 7; const float gam = 1.0f - exp2f(-5.0f - (float)h);
        float S[16];
#pragma unroll
        for (int d = 0; d < 16; ++d) S[d] = 0.f;
        __syncthreads();
        for (int tb = 0; tb < SEQ / 16; ++tb) {
            const size_t rbase = (size_t)b * SEQ + tb * 16;
            { const int idx = 2 * t, tok = idx >> 6, d = idx & 63;
              const unsigned wq = *(const unsigned*)(RQ + (rbase + tok) * 512 + h * 64 + d), wk = *(const unsigned*)(RK + (rbase + tok) * 512 + h * 64 + d);
              Qs[idx] = __builtin_bit_cast(float, wq << 16); Qs[idx + 1] = __builtin_bit_cast(float, wq & 0xffff0000u);
              Ks[idx] = __builtin_bit_cast(float, wk << 16); Ks[idx + 1] = __builtin_bit_cast(float, wk & 0xffff0000u);
              const int iv = 4 * t, tv = iv >> 7, ev = iv & 127; const unsigned long long wv = *(const unsigned long long*)(RV + (rbase + tv) * 1024 + h * 128 + ev);
              const unsigned w0 = (unsigned)wv, w1 = (unsigned)(wv >> 32);
              Vs[iv] = __builtin_bit_cast(float, w0 << 16); Vs[iv + 1] = __builtin_bit_cast(float, w0 & 0xffff0000u); Vs[iv + 2] = __builtin_bit_cast(float, w1 << 16); Vs[iv + 3] = __builtin_bit_cast(float, w1 & 0xffff0000u); }
            __syncthreads();
            for (int tok = 0; tok < 16; ++tok) { const float v = Vs[tok * 128 + e]; float a = 0.f;
#pragma unroll
                for (int d = 0; d < 16; ++d) { S[d] = gam * S[d] + Ks[tok * 64 + d0 + d] * v; a += Qs[tok * 64 + d0 + d] * S[d]; }
                Pt[(tok * 4 + grp) * 128 + e] = a; }
            __syncthreads();
#pragma unroll
            for (int q = 0; q < 2; ++q) { const int tok = 2 * F.wave + q; const size_t row = rbase + tok;
                float o0 = 0.f, o1 = 0.f;
#pragma unroll
                for (int gI = 0; gI < 4; ++gI) { o0 += Pt[(tok * 4 + gI) * 128 + F.lane]; o1 += Pt[(tok * 4 + gI) * 128 + 64 + F.lane]; }
                const float mu = wave_sum(o0 + o1) * (1.0f / 128.0f); const float a0 = o0 - mu, a1 = o1 - mu;
                const float var = wave_sum(a0 * a0 + a1 * a1) * (1.0f / 128.0f); const float rs = 1.0f / sqrtf(var + EPSN);
                bf16* gp = RG + row * 1024 + h * 128;
                const float g0 = __builtin_bit_cast(float, (unsigned)gp[F.lane] << 16), g1 = __builtin_bit_cast(float, (unsigned)gp[64 + F.lane] << 16);
                gp[F.lane] = (bf16)f2bf(a0 * rs * P.gnw[h * 128 + F.lane] * g0); gp[64 + F.lane] = (bf16)f2bf(a1 * rs * P.gnw[h * 128 + 64 + F.lane] * g1); }
        }
    }
}

#ifndef MK_N_LAUNCHES
#define MK_N_LAUNCHES 9
#endif
#ifndef FAST_ATTN
#define FAST_ATTN 0
#endif
#ifndef FAST_RET
#define FAST_RET 0
#endif
constexpr int N_PHASES = 9;
struct Args { const float* in[14]; float* out; unsigned char* ws; int ph_lo, ph_hi; };
__global__ void __launch_bounds__(NWAVES * 64, 2) fwd(Args args) {
    extern __shared__ __attribute__((aligned(16))) unsigned char lds[];
    Frame F;
    F.lds = (LAS unsigned char*)lds;
    F.MISC = (volatile LAS unsigned*)(F.lds + MISC_OFF);
    F.tid = threadIdx.x; F.lane = F.tid & 63; F.wave = __builtin_amdgcn_readfirstlane(F.tid >> 6);
    F.G = gridDim.x; { const int bx = blockIdx.x; F.vcu = (F.G % 8 == 0) ? (bx % 8) * (F.G / 8) + bx / 8 : bx; }
    Ptrs P;
    P.x = args.in[0]; P.c = args.in[1]; P.ln1w = args.in[2]; P.ln2w = args.in[3]; P.wada = args.in[4]; P.bada = args.in[5]; P.win = args.in[6]; P.gnw = args.in[7];
    P.wmo = args.in[8]; P.wro = args.in[9]; P.wout = args.in[10]; P.wff1 = args.in[11]; P.wff2 = args.in[12]; P.fnw = args.in[13]; P.out = args.out; P.ws = args.ws;
    unsigned char* ws = args.ws;
    for (int u = F.tid; u < (LDS_BYTES - LDSCTL_OFF) / 4; u += NWAVES * 64) ((LAS unsigned*)(F.lds + LDSCTL_OFF))[u] = 0u;
    __syncthreads();
    const int lo = args.ph_lo, hi = args.ph_hi;
    XcdBarrier bar; bar.bar = (unsigned*)(ws + WS_CTL) + CW_BAR; bar.x = 0; bar.st = nullptr;
    if (hi - lo > 1) bar = xcd_barrier_post((unsigned*)(ws + WS_CTL) + CW_BAR, F.MISC + 8);
#ifndef PH_MASK
#define PH_MASK 0x1ff
#endif
#define IN(k) (((PH_MASK >> (k)) & 1) && lo <= (k) && (k) < hi)
#define SEAM(k) do { if (IN(k) && IN((k) + 1)) xcd_barrier(bar); } while (0)
    typedef pg8::bf16_t pb;
    const float* ada = (const float*)(ws + WS_ADA);

    if (IN(0)) { phase0(F, P); SEAM(0); }
    if (IN(1)) { phase1(F, P); SEAM(1); }
    if (IN(2)) {
        pg8::Gemm g{(const pb*)(ws + WS_H), (const pb*)(ws + WS_WIN), M, NIN, D}; pg8::StaticOrder S; S.init(M, NIN, F.G, (int)blockIdx.x);
        pg8::EpiIn E{(pb*)(ws + WS_MQ), (pb*)(ws + WS_MK), (pb*)(ws + WS_MV), (pb*)(ws + WS_RQ), (pb*)(ws + WS_RK), (pb*)(ws + WS_RV), (pb*)(ws + WS_RG), (pb*)(ws + WS_SGA), (pb*)(ws + WS_SGR),
                     (const float*)(ws + WS_ROPE), (const float*)(ws + WS_ROPE) + 2048 * 64, (float*)(ws + WS_KSUM), QSCALE};
        pg8::gemm_phase<pg8::EpiIn, pg8::StaticOrder, true, true>(F.lds + RING_OFF, g, S, E);
        SEAM(2);
    }
    if (IN(3)) {
        naive_moba(F, P);
        naive_ret(F, P);
        SEAM(3);
    }
    if (IN(4)) {
        { pg8::Gemm g{(const pb*)(ws + WS_MQ), (const pb*)(ws + WS_WMO), M, D, 512}; pg8::StaticOrder S; S.init(M, D, F.G, (int)blockIdx.x);
          pg8::EpiMerge<false> E{(const pb*)(ws + WS_SGA), (pb*)(ws + WS_H)};
          pg8::gemm_phase<pg8::EpiMerge<false>, pg8::StaticOrder, true, true>(F.lds + RING_OFF, g, S, E); }
        { pg8::Gemm g{(const pb*)(ws + WS_RG), (const pb*)(ws + WS_WRO), M, D, D}; pg8::StaticOrder S; S.init(M, D, F.G, (int)blockIdx.x);
          pg8::EpiMerge<true> E{(const pb*)(ws + WS_SGR), (pb*)(ws + WS_H)};
          pg8::gemm_phase<pg8::EpiMerge<true>, pg8::StaticOrder, true, true>(F.lds + RING_OFF, g, S, E); }
        SEAM(4);
    }
    if (IN(5)) {
        pg8::Gemm g{(const pb*)(ws + WS_H), (const pb*)(ws + WS_WOUT), M, D, D}; pg8::StaticOrder S; S.init(M, D, F.G, (int)blockIdx.x);
        pg8::EpiRes E{P.x, P.out, ada + 2 * D, P.ln2w, ada + 4 * D, (pb*)(ws + WS_A2), (float*)(ws + WS_SS1)};
        pg8::gemm_phase<pg8::EpiRes, pg8::StaticOrder, true, true>(F.lds + RING_OFF, g, S, E);
        SEAM(5);
    }
    if (IN(6)) {
        pg8::Gemm g{(const pb*)(ws + WS_A2), (const pb*)(ws + WS_W1), M, FF, D}; pg8::StaticOrder S; S.init(M, FF, F.G, (int)blockIdx.x);
        pg8::EpiFF1 E{(pb*)(ws + WS_ACT), (const float*)(ws + WS_C1), (const float*)(ws + WS_SS1), EPSN};
        pg8::gemm_phase<pg8::EpiFF1, pg8::StaticOrder, true, true>(F.lds + RING_OFF, g, S, E);
        SEAM(6);
    }
    if (IN(7)) {
        pg8::Gemm g{(const pb*)(ws + WS_ACT), (const pb*)(ws + WS_W2), M, D, FF}; pg8::StaticOrder S; S.init(M, D, F.G, (int)blockIdx.x);
        pg8::EpiRes E{P.out, P.out, ada + 5 * D, nullptr, nullptr, nullptr, (float*)(ws + WS_SS2)};
        pg8::gemm_phase<pg8::EpiRes, pg8::StaticOrder, true, true>(F.lds + RING_OFF, g, S, E);
        SEAM(7);
    }
    if (IN(8)) { phase8(F, P); }
#undef IN
#undef SEAM
}

extern "C" void kernel_launch(void* const* d_in, const int* in_sizes, int n_in, void* d_out, int out_size, void* d_ws, size_t ws_size, hipStream_t stream) {
    static int grid = 0;
    if (grid == 0) {
        if (n_in != 14 || in_sizes[0] != M * D || out_size != M * D || ws_size < WS_END) { fprintf(stderr, "kernel_launch: shape/workspace mismatch: n_in %d in0 %d out %d ws %zu (need %zu)\n", n_in, n_in > 0 ? in_sizes[0] : -1, out_size, ws_size, (size_t)WS_END); grid = -1; return; }
        int dev = 0, cus = 0, per_cu = 0;
        if (hipGetDevice(&dev) != hipSuccess || hipDeviceGetAttribute(&cus, hipDeviceAttributeMultiprocessorCount, dev) != hipSuccess) { grid = -1; return; }
        if (hipFuncSetAttribute((const void*)fwd, hipFuncAttributeMaxDynamicSharedMemorySize, LDS_BYTES) != hipSuccess) { fprintf(stderr, "kernel_launch: hipFuncSetAttribute failed\n"); grid = -1; return; }
        if (hipOccupancyMaxActiveBlocksPerMultiprocessor(&per_cu, (const void*)fwd, NWAVES * 64, LDS_BYTES) != hipSuccess || per_cu < 1) { fprintf(stderr, "kernel_launch: occupancy query says %d blocks per CU\n", per_cu); }
        (void)hipGetLastError();
        grid = cus;
    }
    if (grid < 0) return;
    if (hipMemsetAsync((char*)d_ws + WS_CTL, 0, ZERO_BYTES, stream) != hipSuccess) { fprintf(stderr, "kernel_launch: memset failed\n"); return; }
    Args a{};
    for (int i = 0; i < 14; ++i) a.in[i] = (const float*)d_in[i];
    a.out = (float*)d_out; a.ws = (unsigned char*)d_ws;
    if (MK_N_LAUNCHES == 1) { a.ph_lo = 0; a.ph_hi = N_PHASES; hipLaunchKernelGGL(fwd, dim3(grid), dim3(NWAVES * 64), LDS_BYTES, stream, a); }
    else for (int li = 0; li < N_PHASES; ++li) { a.ph_lo = li; a.ph_hi = li + 1; hipLaunchKernelGGL(fwd, dim3(grid), dim3(NWAVES * 64), LDS_BYTES, stream, a); }
    const hipError_t le = hipPeekAtLastError();
    if (le != hipSuccess) fprintf(stderr, "kernel_launch: launch failed: %s\n", hipGetErrorName(le));
}
```

```cpp
#include <hip/hip_runtime.h>
#include <cstdio>
#include <cstdint>
#include <cmath>
namespace pg8 {
#define PG8_LAS __attribute__((address_space(3)))
typedef unsigned short bf16_t;
typedef short bf16x8 __attribute__((ext_vector_type(8)));
typedef float f32x4 __attribute__((ext_vector_type(4)));
typedef unsigned u32x4 __attribute__((ext_vector_type(4)));
constexpr int BM = 256, BK = 64, HALF = 128, HTB = HALF * BK * 2  , STAGE_BYTES = 8 * HTB, NXCD = 8, WGM = 8;

__host__ __device__ __forceinline__ int lds_byte(int r, int c) { const int st = (r >> 4) * 2 + (c >> 5), rr = r & 15, cc = c & 31, ob = rr * 64 + cc * 2; return st * 1024 + (ob ^ (((ob >> 9) & 1) << 5)); }
__host__ __device__ __forceinline__ void stage_rc(int b, int& R, int& C) { const int st = b / 1024, sb = b % 1024, swz = sb ^ (((sb >> 9) & 1) << 5); R = (st >> 1) * 16 + swz / 64; C = (st & 1) * 32 + (swz % 64) / 2; }
__host__ __device__ __forceinline__ int perm32(int rho) { const int n = rho >> 4, i = rho & 15; return 8 * (i >> 2) + 4 * n + (i & 3); }

struct Unit { int pm, pn; };
struct Gemm { const bf16_t* A; const bf16_t* Bt; int M, N, K; };

struct StaticOrder {
    int nM, nN, nwg, G, c;
    __host__ __device__ void init(int M, int N, int G_, int c_) { nM = M / BM; nN = N / BM; nwg = nM * nN; G = G_; c = c_; }
    __host__ __device__ bool next(int i, Unit& u) const {
        const long L = (long)i * G + c; if (L >= nwg) return false;
        int wgid = (int)L; { const int q = nwg / NXCD, r = nwg % NXCD, xcd = wgid % NXCD, off = wgid / NXCD; wgid = (xcd < r ? xcd * (q + 1) : r * (q + 1) + (xcd - r) * q) + off; }
        const int nig = WGM * nN, gid = wgid / nig, fm = gid * WGM, gsz = (nM - fm) < WGM ? (nM - fm) : WGM;
        u.pm = fm + ((wgid % nig) % gsz); u.pn = (wgid % nig) / gsz; return true;
    }
    __device__ __forceinline__ void a_ready(const Unit&) const {}
    __device__ __forceinline__ void done(const Unit&) const {}
};

__device__ __forceinline__ unsigned cvt_pk_bf16(float lo, float hi) { unsigned r; asm volatile("v_cvt_pk_bf16_f32 %0, %1, %2" : "=v"(r) : "v"(lo), "v"(hi)); return r; }
typedef float f32x2 __attribute__((ext_vector_type(2)));
typedef unsigned u32x2 __attribute__((ext_vector_type(2)));
__device__ __forceinline__ float sigm(float x) { return __builtin_amdgcn_rcpf(1.f + __builtin_amdgcn_exp2f(-1.4426950408889634f * x)); }
__device__ __forceinline__ float bf_lo(unsigned w) { return __builtin_bit_cast(float, w << 16); }
__device__ __forceinline__ float bf_hi(unsigned w) { return __builtin_bit_cast(float, w & 0xffff0000u); }
__device__ __forceinline__ u32x4 pack8(f32x4 a, f32x4 b) { u32x4 w; w.x = cvt_pk_bf16(a[0], a[1]); w.y = cvt_pk_bf16(a[2], a[3]); w.z = cvt_pk_bf16(b[0], b[1]); w.w = cvt_pk_bf16(b[2], b[3]); return w; }

struct EpiIn {
    static constexpr bool PERM = true, AFTER_DRAIN = false;
    bf16_t *MQ, *MK, *MV, *RQ, *RK, *RV, *RG, *SGA, *SGR; const float* rope_moba; const float* rope_ret; float* ksum; float qscale;
    __device__ __forceinline__ void operator()(const f32x4 (&acc)[2][2][4][2], const Unit& u, int wr, int wc, int fr, int fq) const {
        const int pn = u.pn; const int row0 = u.pm * BM + wr * 64 + fr;
        bf16_t* base; int ldc, colt, mode; float sc = 1.f; const float* tab = rope_moba;
        if (pn < 2)       { base = MQ;  ldc = 512;  colt = pn * 256;        mode = 1; sc = qscale; }
        else if (pn < 4)  { base = MK;  ldc = 512;  colt = (pn - 2) * 256;  mode = 1; }
        else if (pn < 6)  { base = MV;  ldc = 512;  colt = (pn - 4) * 256;  mode = 0; }
        else if (pn < 8)  { base = RQ;  ldc = 512;  colt = (pn - 6) * 256;  mode = 1; tab = rope_ret; }
        else if (pn < 10) { base = RK;  ldc = 512;  colt = (pn - 8) * 256;  mode = 1; tab = rope_ret; sc = 0.125f; }
        else if (pn < 14) { base = RV;  ldc = 1024; colt = (pn - 10) * 256; mode = 0; }
        else if (pn < 18) { base = RG;  ldc = 1024; colt = (pn - 14) * 256; mode = 2; }
        else if (pn < 22) { base = SGA; ldc = 1024; colt = (pn - 18) * 256; mode = 3; }
        else              { base = SGR; ldc = 1024; colt = (pn - 22) * 256; mode = 3; }
        const int col0 = colt + wc * 32 + 8 * fq;
        if (mode == 1) {
            const int g = 4 * (wc & 1) + fq; const bool isk = (pn == 2 || pn == 3);
            f32x4 ks[2][2];
#pragma unroll
            for (int bj = 0; bj < 2; ++bj)
#pragma unroll
                for (int n = 0; n < 2; ++n) ks[bj][n] = (f32x4){0.f, 0.f, 0.f, 0.f};
#pragma unroll
            for (int ai = 0; ai < 2; ++ai)
#pragma unroll
                for (int m = 0; m < 4; ++m) {
                    const int row = row0 + ai * HALF + m * 16; const int pos = row & 2047;
                    const f32x4 cs = *(const f32x4*)(tab + pos * 64 + 4 * g), sn = *(const f32x4*)(tab + pos * 64 + 32 + 4 * g);
                    bf16_t* rowp = base + (size_t)row * ldc + col0;
#pragma unroll
                    for (int bj = 0; bj < 2; ++bj) {
                        const f32x4 v0 = acc[ai][bj][m][0], v1 = acc[ai][bj][m][1];
                        const f32x4 o0 = (v0 * cs - v1 * sn) * sc, o1 = (v0 * sn + v1 * cs) * sc;
                        if (isk) { ks[bj][0] += o0; ks[bj][1] += o1; }
                        *(u32x4*)(rowp + bj * HALF) = pack8(o0, o1);
                    }
                }
            if (isk) {
#pragma unroll
                for (int bj = 0; bj < 2; ++bj)
#pragma unroll
                    for (int n = 0; n < 2; ++n)
#pragma unroll
                        for (int e = 0; e < 4; ++e) { float s = ks[bj][n][e]; s += __shfl_xor(s, 1); s += __shfl_xor(s, 2); s += __shfl_xor(s, 4); s += __shfl_xor(s, 8);
                            if (fr == 0) atomicAdd(ksum + (size_t)u.pm * 512 + col0 + bj * HALF + 4 * n + e, s); }
            }
        } else {
#pragma unroll
            for (int ai = 0; ai < 2; ++ai)
#pragma unroll
                for (int m = 0; m < 4; ++m) {
                    bf16_t* rowp = base + (size_t)(row0 + ai * HALF + m * 16) * ldc + col0;
#pragma unroll
                    for (int bj = 0; bj < 2; ++bj) {
                        f32x4 v0 = acc[ai][bj][m][0], v1 = acc[ai][bj][m][1];
                        if (mode >= 2) {
#pragma unroll
                            for (int e = 0; e < 4; ++e) { const float s0 = sigm(v0[e]), s1 = sigm(v1[e]); v0[e] = (mode == 2) ? v0[e] * s0 : s0; v1[e] = (mode == 2) ? v1[e] * s1 : s1; }
                        }
                        *(u32x4*)(rowp + bj * HALF) = pack8(v0, v1);
                    }
                }
        }
    }
};

template <bool ADD> struct EpiMerge {
    static constexpr bool PERM = true, AFTER_DRAIN = false;
    const bf16_t* gate; bf16_t* out;
    __device__ __forceinline__ void operator()(const f32x4 (&acc)[2][2][4][2], const Unit& u, int wr, int wc, int fr, int fq) const {
        const int row0 = u.pm * BM + wr * 64 + fr, col0 = u.pn * BM + wc * 32 + 8 * fq;
#pragma unroll
        for (int ai = 0; ai < 2; ++ai)
#pragma unroll
            for (int m = 0; m < 4; ++m) {
                const size_t off = (size_t)(row0 + ai * HALF + m * 16) * 1024 + col0;
#pragma unroll
                for (int bj = 0; bj < 2; ++bj) {
                    const u32x4 gw = *(const u32x4*)(gate + off + bj * HALF);
                    f32x4 v0 = acc[ai][bj][m][0], v1 = acc[ai][bj][m][1];
                    v0[0] *= bf_lo(gw.x); v0[1] *= bf_hi(gw.x); v0[2] *= bf_lo(gw.y); v0[3] *= bf_hi(gw.y);
                    v1[0] *= bf_lo(gw.z); v1[1] *= bf_hi(gw.z); v1[2] *= bf_lo(gw.w); v1[3] *= bf_hi(gw.w);
                    if (ADD) { const u32x4 pw = *(const u32x4*)(out + off + bj * HALF);
                        v0[0] += bf_lo(pw.x); v0[1] += bf_hi(pw.x); v0[2] += bf_lo(pw.y); v0[3] += bf_hi(pw.y);
                        v1[0] += bf_lo(pw.z); v1[1] += bf_hi(pw.z); v1[2] += bf_lo(pw.w); v1[3] += bf_hi(pw.w); }
                    *(u32x4*)(out + off + bj * HALF) = pack8(v0, v1);
                }
            }
    }
};

struct EpiRes {
    static constexpr bool PERM = false, AFTER_DRAIN = false;
    const float* xin; float* xo; const float* gvec  ; const float* lnw; const float* scv  ; bf16_t* A2; float* ss;
    __device__ __forceinline__ void operator()(const f32x4 (&acc)[2][2][4][2], const Unit& u, int wr, int wc, int fr, int fq) const {
        const int row0 = u.pm * BM + wr * 64 + fr, col0 = u.pn * BM + wc * 32 + 4 * fq; const int b = u.pm >> 3;
        f32x4 gv[2][2], we[2][2];
#pragma unroll
        for (int bj = 0; bj < 2; ++bj)
#pragma unroll
            for (int n = 0; n < 2; ++n) { const int c = col0 + bj * HALF + n * 16; gv[bj][n] = *(const f32x4*)(gvec + (size_t)b * 6144 + c);
                if (A2) { const f32x4 w = *(const f32x4*)(lnw + c), s = *(const f32x4*)(scv + (size_t)b * 6144 + c); we[bj][n] = w * (s + 1.0f); } else we[bj][n] = (f32x4){0.f, 0.f, 0.f, 0.f}; }
#pragma unroll
        for (int ai = 0; ai < 2; ++ai)
#pragma unroll
            for (int m = 0; m < 4; ++m) {
                const int row = row0 + ai * HALF + m * 16; const size_t off = (size_t)row * 1024 + col0; float q = 0.f;
#pragma unroll
                for (int bj = 0; bj < 2; ++bj)
#pragma unroll
                    for (int n = 0; n < 2; ++n) { const size_t o = off + bj * HALF + n * 16; const f32x4 xv = *(const f32x4*)(xin + o);
                        const f32x4 x1 = xv + gv[bj][n] * acc[ai][bj][m][n]; *(f32x4*)(xo + o) = x1; q += (x1[0] * x1[0] + x1[1] * x1[1]) + (x1[2] * x1[2] + x1[3] * x1[3]);
                        if (A2) { const f32x4 a = x1 * we[bj][n]; u32x2 w; w.x = cvt_pk_bf16(a[0], a[1]); w.y = cvt_pk_bf16(a[2], a[3]); *(u32x2*)(A2 + o) = w; } }
                q += __shfl_xor(q, 16); q += __shfl_xor(q, 32);
                if (fq == 0) atomicAdd(ss + row, q);
            }
    }
};

struct EpiFF1 {
    static constexpr bool PERM = true, AFTER_DRAIN = false;
    bf16_t* O; const float* c1; const float* ss; float eps;
    __device__ __forceinline__ void operator()(const f32x4 (&acc)[2][2][4][2], const Unit& u, int wr, int wc, int fr, int fq) const {
        const int row0 = u.pm * BM + wr * 64 + fr, col0 = u.pn * BM + wc * 32 + 8 * fq; const int b = u.pm >> 3;
        f32x4 cv[2][2];
#pragma unroll
        for (int bj = 0; bj < 2; ++bj)
#pragma unroll
            for (int n = 0; n < 2; ++n) cv[bj][n] = *(const f32x4*)(c1 + (size_t)b * 4096 + col0 + bj * HALF + 4 * n);
#pragma unroll
        for (int ai = 0; ai < 2; ++ai)
#pragma unroll
            for (int m = 0; m < 4; ++m) {
                const int row = row0 + ai * HALF + m * 16; const float rs = 1.0f / sqrtf(ss[row] * (1.0f / 1024.0f) + eps);
                bf16_t* rowp = O + (size_t)row * 4096 + col0;
#pragma unroll
                for (int bj = 0; bj < 2; ++bj) {
                    f32x4 v0 = acc[ai][bj][m][0] * rs + cv[bj][0], v1 = acc[ai][bj][m][1] * rs + cv[bj][1];
#pragma unroll
                    for (int e = 0; e < 4; ++e) { const float a = fmaxf(v0[e], 0.f), c = fmaxf(v1[e], 0.f); v0[e] = a * a; v1[e] = c * c; }
                    *(u32x4*)(rowp + bj * HALF) = pack8(v0, v1);
                }
            }
    }
};
template <class Epi, class Sched, bool ALIGN_EPI = false, bool SP2 = false>
__device__ __forceinline__ void gemm_phase(PG8_LAS unsigned char* lds, const Gemm g, const Sched& S, const Epi& E) {
    const int tid = threadIdx.x, wid = __builtin_amdgcn_readfirstlane(tid >> 6), lane = tid & 63, wr = wid >> 2, wc = wid & 3, fr = lane & 15, fq = lane >> 4;
    const int K = g.K, nt = K / BK;
    unsigned voffA[2], voffB[2];
#pragma unroll
    for (int i = 0; i < 2; ++i) { int R, C; stage_rc(tid * 16 + i * 8192, R, C); const int Rb = Epi::PERM ? ((R & ~31) + perm32(R & 31)) : R;
        voffA[i] = (unsigned)(R * K + C) * 2u; voffB[i] = (unsigned)(Rb * K + C) * 2u; }
    const size_t kstep = (size_t)(BK * 2);
    const size_t hstep = (size_t)HALF * K * 2;
    const size_t tstep = 2 * hstep;
    const unsigned ldsw = (unsigned)wid * 1024u;
    const int aoff = lds_byte(wr * 64 + fr, fq * 8), boff = lds_byte(wc * 32 + fr, fq * 8);
#define PG8_SA(b, h) (((b) * 2 + (h)) * HTB)
#define PG8_SB(b, h) ((4 + (b) * 2 + (h)) * HTB)
#define PG8_STAGE(bufoff, gbase, voff) do { _Pragma("unroll") for (int _i = 0; _i < 2; ++_i) \
        __builtin_amdgcn_global_load_lds((const unsigned*)((const char*)(gbase) + (voff)[_i]), (PG8_LAS unsigned*)(lds + (bufoff) + ldsw + _i * 8192), 16, 0, 0); } while (0)
#define PG8_LDA(dst, b, h) do { _Pragma("unroll") for (int m = 0; m < 4; ++m) _Pragma("unroll") for (int k = 0; k < 2; ++k) dst[m][k] = *(const PG8_LAS bf16x8*)(lds + PG8_SA(b, h) + aoff + m * 2048 + k * 1024); } while (0)
#define PG8_LDB(dst, b, h) do { _Pragma("unroll") for (int n = 0; n < 2; ++n) _Pragma("unroll") for (int k = 0; k < 2; ++k) dst[n][k] = *(const PG8_LAS bf16x8*)(lds + PG8_SB(b, h) + boff + n * 2048 + k * 1024); } while (0)
#define PG8_MMA(ai, bj, At, Bt) do { __builtin_amdgcn_s_setprio(1); _Pragma("unroll") for (int m = 0; m < 4; ++m) _Pragma("unroll") for (int n = 0; n < 2; ++n) _Pragma("unroll") for (int k = 0; k < 2; ++k) \
        acc[ai][bj][m][n] = __builtin_amdgcn_mfma_f32_16x16x32_bf16(Bt[n][k], At[m][k], acc[ai][bj][m][n], 0, 0, 0); __builtin_amdgcn_s_setprio(0); } while (0)
#define PG8_WAIT_V(n) asm volatile("s_waitcnt vmcnt(" #n ")" ::: "memory")
#define PG8_WAIT_L(n) asm volatile("s_waitcnt lgkmcnt(" #n ")" ::: "memory")
#define PG8_BAR __builtin_amdgcn_s_barrier()
#define PG8_SCHED __builtin_amdgcn_sched_barrier(0)
    Unit cur, nxt; int ui = 0;
    if (!S.next(0, cur)) return;
    f32x4 acc[2][2][4][2];
#pragma unroll
    for (int a = 0; a < 2; ++a)
#pragma unroll
        for (int b = 0; b < 2; ++b)
#pragma unroll
            for (int m = 0; m < 4; ++m)
#pragma unroll
                for (int n = 0; n < 2; ++n) acc[a][b][m][n] = (f32x4){0.f, 0.f, 0.f, 0.f};
    bf16x8 At[4][2], B0[2][2], B1[2][2];
    const char* cA = (const char*)g.A + (size_t)cur.pm * tstep; const char* cB = (const char*)g.Bt + (size_t)cur.pn * tstep;
    S.a_ready(cur);
    if constexpr (SP2) {
        PG8_STAGE(PG8_SB(0, 0), cB, voffB); PG8_STAGE(PG8_SB(0, 1), cB + hstep, voffB); PG8_STAGE(PG8_SA(0, 0), cA, voffA); PG8_STAGE(PG8_SA(0, 1), cA + hstep, voffA);
        if (wr == 1) PG8_BAR;
        PG8_WAIT_V(2); PG8_BAR;
        PG8_STAGE(PG8_SB(1, 0), cB + kstep, voffB); PG8_STAGE(PG8_SA(1, 0), cA + kstep, voffA); PG8_STAGE(PG8_SB(1, 1), cB + hstep + kstep, voffB);
        PG8_WAIT_V(6); PG8_BAR;
    } else {
        PG8_STAGE(PG8_SB(0, 0), cB, voffB); PG8_STAGE(PG8_SA(0, 0), cA, voffA); PG8_STAGE(PG8_SB(0, 1), cB + hstep, voffB); PG8_STAGE(PG8_SA(0, 1), cA + hstep, voffA);
        if (wr == 1) PG8_BAR;
        PG8_WAIT_V(4); PG8_BAR;
        PG8_STAGE(PG8_SB(1, 0), cB + kstep, voffB); PG8_STAGE(PG8_SA(1, 0), cA + kstep, voffA); PG8_STAGE(PG8_SB(1, 1), cB + hstep + kstep, voffB);
        PG8_WAIT_V(6); PG8_BAR;
    }
    for (;;) {
        const bool has_next = S.next(ui + 1, nxt);
        const char* nA = has_next ? (const char*)g.A + (size_t)nxt.pm * tstep : cA; const char* nB = has_next ? (const char*)g.Bt + (size_t)nxt.pn * tstep : cB;
        for (int t = 0; t < nt; t += 2) {
            const bool last = (t == nt - 2);
            const char* a1 = cA + (size_t)(t + 1) * kstep;
            const char* a2 = last ? nA : cA + (size_t)(t + 2) * kstep; const char* b2 = last ? nB : cB + (size_t)(t + 2) * kstep;
            const char* a3 = a2 + kstep; const char* b3 = b2 + kstep;
            if (last && has_next) S.a_ready(nxt);
            if constexpr (SP2) {
            PG8_LDB(B0, 0, 0); PG8_LDB(B1, 0, 1); PG8_SCHED; PG8_LDA(At, 0, 0); PG8_STAGE(PG8_SA(1, 1), a1 + hstep, voffA);
            PG8_WAIT_V(8); PG8_WAIT_L(0); PG8_BAR; PG8_MMA(0, 0, At, B0); PG8_MMA(0, 1, At, B1); PG8_BAR; PG8_SCHED;
            PG8_LDA(At, 0, 1); PG8_STAGE(PG8_SB(0, 0), b2, voffB); PG8_STAGE(PG8_SB(0, 1), b2 + hstep, voffB); PG8_STAGE(PG8_SA(0, 0), a2, voffA);
            PG8_WAIT_V(8); PG8_WAIT_L(0); PG8_BAR; PG8_MMA(1, 0, At, B0); PG8_MMA(1, 1, At, B1); PG8_BAR; PG8_SCHED;
            PG8_LDB(B0, 1, 0); PG8_LDB(B1, 1, 1); PG8_SCHED; PG8_LDA(At, 1, 0); PG8_STAGE(PG8_SA(0, 1), a2 + hstep, voffA);
            PG8_WAIT_V(8); PG8_WAIT_L(0); PG8_BAR; PG8_MMA(0, 0, At, B0); PG8_MMA(0, 1, At, B1); PG8_BAR; PG8_SCHED;
            PG8_LDA(At, 1, 1); PG8_STAGE(PG8_SB(1, 0), b3, voffB); PG8_STAGE(PG8_SB(1, 1), b3 + hstep, voffB); PG8_STAGE(PG8_SA(1, 0), a3, voffA);
            PG8_WAIT_V(8); PG8_WAIT_L(0); PG8_BAR; PG8_MMA(1, 0, At, B0); PG8_MMA(1, 1, At, B1); PG8_BAR; PG8_SCHED;
            } else {
            PG8_LDB(B0, 0, 0); PG8_SCHED; PG8_LDA(At, 0, 0); PG8_STAGE(PG8_SA(1, 1), a1 + hstep, voffA);
            PG8_WAIT_L(8); PG8_BAR; PG8_WAIT_L(0); PG8_MMA(0, 0, At, B0); PG8_BAR; PG8_SCHED;
            PG8_LDB(B1, 0, 1); PG8_STAGE(PG8_SB(0, 0), b2, voffB);
            PG8_BAR; PG8_WAIT_L(0); PG8_MMA(0, 1, At, B1); PG8_BAR;
            PG8_LDA(At, 0, 1); PG8_STAGE(PG8_SA(0, 0), a2, voffA);
            PG8_BAR; PG8_WAIT_L(0); PG8_MMA(1, 0, At, B0); PG8_BAR; PG8_SCHED;
            PG8_STAGE(PG8_SB(0, 1), b2 + hstep, voffB);
            PG8_WAIT_V(6); PG8_BAR; PG8_MMA(1, 1, At, B1); PG8_BAR;
            PG8_LDB(B0, 1, 0); PG8_SCHED; PG8_LDA(At, 1, 0); PG8_STAGE(PG8_SA(0, 1), a2 + hstep, voffA);
            PG8_WAIT_L(8); PG8_BAR; PG8_WAIT_L(0); PG8_MMA(0, 0, At, B0); PG8_BAR; PG8_SCHED;
            PG8_LDB(B1, 1, 1); PG8_STAGE(PG8_SB(1, 0), b3, voffB);
            PG8_BAR; PG8_WAIT_L(0); PG8_MMA(0, 1, At, B1); PG8_BAR;
            PG8_LDA(At, 1, 1); PG8_STAGE(PG8_SA(1, 0), a3, voffA);
            PG8_BAR; PG8_WAIT_L(0); PG8_MMA(1, 0, At, B0); PG8_BAR; PG8_SCHED;
            PG8_STAGE(PG8_SB(1, 1), b3 + hstep, voffB);
            PG8_WAIT_V(6); PG8_BAR; PG8_MMA(1, 1, At, B1); PG8_BAR;
            }
        }
        if constexpr (ALIGN_EPI) { if (wr == 0) PG8_BAR; }
        if constexpr (!Epi::AFTER_DRAIN) { E(acc, cur, wr, wc, fr, fq); S.done(cur); }
        if (!has_next) break;
#pragma unroll
        for (int a = 0; a < 2; ++a)
#pragma unroll
            for (int b = 0; b < 2; ++b)
#pragma unroll
                for (int m = 0; m < 4; ++m)
#pragma unroll
                    for (int n = 0; n < 2; ++n) acc[a][b][m][n] = (f32x4){0.f, 0.f, 0.f, 0.f};
        cur = nxt; cA = nA; cB = nB; ++ui;
        if constexpr (ALIGN_EPI) { if (wr == 1) PG8_BAR; }
    }
    PG8_WAIT_V(0);
    if constexpr (!ALIGN_EPI) { if (wr == 0) PG8_BAR; }
    PG8_BAR;
    if constexpr (Epi::AFTER_DRAIN) { E.fused(acc, cur, wr, wc, fr, fq, lds, wid, lane); S.done(cur); }
#undef PG8_SA
#undef PG8_SB
#undef PG8_STAGE
#undef PG8_LDA
#undef PG8_LDB
#undef PG8_MMA
#undef PG8_WAIT_V
#undef PG8_WAIT_L
#undef PG8_BAR
#undef PG8_SCHED
}
}
#define GAS __attribute__((address_space(1)))
#define LAS __attribute__((address_space(3)))
typedef unsigned short bf16;
typedef unsigned v4u __attribute__((ext_vector_type(4)));
typedef float f32x4 __attribute__((ext_vector_type(4)));
typedef short bf16x8 __attribute__((ext_vector_type(8)));
typedef GAS unsigned gu32;
typedef GAS unsigned long long gu64;
#define RLX_AGENT __ATOMIC_RELAXED, __HIP_MEMORY_SCOPE_AGENT
#define LDS_WAIT() asm volatile("s_waitcnt lgkmcnt(0)" ::: "memory")
#define VM_WAIT() asm volatile("s_waitcnt vmcnt(0)" ::: "memory")
__device__ __forceinline__ unsigned long long rt() { return __builtin_amdgcn_s_memrealtime(); }
__device__ __forceinline__ unsigned f2bf(float f) { unsigned u = __builtin_bit_cast(unsigned, f); return (u + 0x7fffu + ((u >> 16) & 1u)) >> 16; }
__device__ __forceinline__ unsigned pk2(float lo, float hi) { return f2bf(lo) | (f2bf(hi) << 16); }

#define XB_TMO      128
#define XB_XCNT(j)  (256  + 64 * (j))
#define XB_XSUB(j)  (1280 + 64 * (j))
#define XB_XGEN(j)  (2304 + 64 * (j))
#define XB_TOP      3328
#define XB_TOPGEN   3392
#define XCD_BAR_WORDS 3456
#define XB_SPIN_CAP (1u << 18)

__device__ __forceinline__ unsigned xb_ld(unsigned* p)              { return __hip_atomic_load(p, __ATOMIC_RELAXED, __HIP_MEMORY_SCOPE_AGENT); }
__device__ __forceinline__ unsigned xb_add(unsigned* p, unsigned v) { return __hip_atomic_fetch_add(p, v, __ATOMIC_RELAXED, __HIP_MEMORY_SCOPE_AGENT); }
__device__ __forceinline__ unsigned xb_xcc_id() { return (unsigned)__builtin_amdgcn_s_getreg((3 << 11) | 20) & 0xFu; }
#define XB_SPIN(cond, bar) do { unsigned _sp = 0; while (cond) { __builtin_amdgcn_s_sleep(1); \
    if ((++_sp & 255u) == 0u) { if (xb_ld(&(bar)[XB_TMO])) break; if (_sp > XB_SPIN_CAP) { atomicAdd(&(bar)[XB_TMO], 1u); break; } } } } while (0)

struct XcdBarrier {
    unsigned* bar; unsigned x;
    volatile LAS unsigned* st;
};

__device__ __forceinline__ XcdBarrier xcd_barrier_post(unsigned* bar, volatile LAS unsigned* st) {
    XcdBarrier b; b.bar = bar; b.x = xb_xcc_id(); b.st = st;
    if (threadIdx.x == 0) (void)xb_add(&bar[XB_XCNT(b.x)], 1u);
    return b;
}
__device__ __forceinline__ void xcd_barrier_complete(unsigned* bar, unsigned x, unsigned& nloc, unsigned& nx) {
    const unsigned G = gridDim.x * gridDim.y * gridDim.z;
    unsigned sum, cnt, mine, sp = 0u;
    for (;;) {
        sum = 0u; cnt = 0u; mine = 0u;
#pragma unroll
        for (unsigned j = 0; j < 16; ++j) { const unsigned c = xb_ld(&bar[XB_XCNT(j)]); sum += c; cnt += (c > 0u) ? 1u : 0u; mine = (j == x) ? c : mine; }
        if (sum == G) break;
        __builtin_amdgcn_s_sleep(1);
        if ((++sp & 255u) == 0u) { if (xb_ld(&bar[XB_TMO])) break; if (sp > XB_SPIN_CAP) { atomicAdd(&bar[XB_TMO], 1u); break; } }
    }
    nloc = mine > 0u ? mine : 1u; nx = cnt > 0u ? cnt : 1u;
}

__device__ __forceinline__ void xcd_barrier(const XcdBarrier& b) {
    asm volatile("s_waitcnt vmcnt(0)" ::: "memory");
    __syncthreads();
    if (threadIdx.x == 0) {
        unsigned* bar = b.bar;
        __builtin_amdgcn_s_waitcnt(0);
        unsigned nloc = b.st[0], nx = b.st[1];
        if (nloc == 0u) { xcd_barrier_complete(bar, b.x, nloc, nx); b.st[0] = nloc; b.st[1] = nx; }
        const unsigned old = xb_add(&bar[XB_XSUB(b.x)], 1u);
        const unsigned gen = old / nloc;
        if (old + 1u == (gen + 1u) * nloc) {
            __builtin_amdgcn_fence(__ATOMIC_RELEASE, "agent");
            asm volatile("s_waitcnt vmcnt(0)" ::: "memory");
            const unsigned og = xb_add(&bar[XB_TOP], 1u);
            const unsigned tg = og / nx;
            if (og + 1u == (tg + 1u) * nx) xb_add(&bar[XB_TOPGEN], 1u);
            else XB_SPIN(xb_ld(&bar[XB_TOPGEN]) == tg, bar);
            __builtin_amdgcn_fence(__ATOMIC_ACQUIRE, "agent");
            xb_add(&bar[XB_XGEN(b.x)], 1u);
            asm volatile("s_waitcnt vmcnt(0)" ::: "memory");
        } else {
            XB_SPIN(xb_ld(&bar[XB_XGEN(b.x)]) == gen, bar);
            __builtin_amdgcn_fence(__ATOMIC_ACQUIRE, "agent");
            asm volatile("s_waitcnt vmcnt(0)" ::: "memory");
        }
    }
    __syncthreads();
}

constexpr int NWAVES = 8;
constexpr int BATCH = 32, SEQ = 2048, D = 1024, FF = 4096, NIN = 6656, NADA = 6144;
constexpr int M = BATCH * SEQ;
constexpr float EPSN = 1e-6f;
constexpr float QSCALE = 0.125f * 1.4426950408889634f;
constexpr size_t KiB = 1024, MiB = 1u << 20;
constexpr size_t WS_CTL = 0;
constexpr size_t WS_ADA = 64 * KiB;
constexpr size_t WS_C1 = 832 * KiB;
constexpr size_t WS_KSUM = 1344 * KiB;
constexpr size_t WS_SS1 = 1856 * KiB;
constexpr size_t WS_SS2 = 2112 * KiB;
constexpr size_t ZERO_BYTES = 2560 * KiB;
constexpr size_t WS_ROPE = 3 * MiB;
constexpr size_t WS_WIN = 8 * MiB, WS_WMO = 21 * MiB, WS_WRO = 22 * MiB, WS_WOUT = 24 * MiB, WS_W1 = 26 * MiB, WS_W2 = 34 * MiB;
constexpr size_t WS_H = 48 * MiB;
constexpr size_t WS_MQ = 176 * MiB, WS_MK = 240 * MiB, WS_MV = 304 * MiB, WS_RQ = 368 * MiB, WS_RK = 432 * MiB;
constexpr size_t WS_RV = 496 * MiB, WS_RG = 624 * MiB, WS_SGA = 752 * MiB, WS_SGR = 880 * MiB;
constexpr size_t WS_A2 = 240 * MiB;
constexpr size_t WS_ACT = 496 * MiB;
constexpr size_t WS_END = 1008 * MiB;
constexpr int CW_BAR = 4096;
constexpr int RING_OFF = 0, RING_BYTES = 131072;
constexpr int LDSCTL_OFF = RING_BYTES, MISC_OFF = LDSCTL_OFF + 320;
constexpr int LDS_BYTES = 147456;

struct Frame {
    LAS unsigned char* lds;
    volatile LAS unsigned* MISC;
    int tid, lane, wave, vcu, G;
};

__device__ __forceinline__ float wave_sum(float v) {
#pragma unroll
    for (int o = 1; o < 64; o <<= 1) v += __shfl_xor(v, o);
    return v;
}
__device__ __forceinline__ int win_dst_row(int n) {
    const bool qk = (n < 1024) || (n >= 1536 && n < 2560);
    if (!qk) return n;
    const int d = n & 63, s = d >> 5, i = d & 31;
    return (n & ~63) + 8 * (i >> 2) + 4 * s + (i & 3);
}
template <bool PERMUTE>
__device__ __forceinline__ void p0_transpose_item(const float* W, int K, int N, bf16* WT, LAS float* scr, int item, int lane) {
    const int nblk = N / 32, kb = item / nblk, nb = item % nblk, k0 = 64 * kb, n0 = 32 * nb;
#pragma unroll 8
    for (int i = 0; i < 32; ++i) { const int kk = 2 * i + (lane >> 5); scr[kk * 33 + (lane & 31)] = W[(size_t)(k0 + kk) * N + n0 + (lane & 31)]; }
    LDS_WAIT(); asm volatile("" ::: "memory");
    const int c = lane & 7;
#pragma unroll
    for (int j = 0; j < 4; ++j) { const int n = (lane >> 3) + 8 * j; const LAS float* s = scr + (8 * c) * 33 + n;
        v4u o; o.x = pk2(s[0 * 33], s[1 * 33]); o.y = pk2(s[2 * 33], s[3 * 33]); o.z = pk2(s[4 * 33], s[5 * 33]); o.w = pk2(s[6 * 33], s[7 * 33]);
        const int drow = PERMUTE ? win_dst_row(n0 + n) : (n0 + n);
        *(GAS v4u*)(WT + (size_t)drow * K + k0 + 8 * c) = o; }
    LDS_WAIT(); asm volatile("" ::: "memory");
}
typedef float f32x16 __attribute__((ext_vector_type(16)));
template <bool SILU>
__device__ __forceinline__ void gemv32_item(const float* in, int ldin, const float* W, int N, const float* bias, float* out, int ldout, int k0, int KS, int n0, int lane) {
    const int r = lane & 31, hh = lane >> 5;
    f32x16 acc;
#pragma unroll
    for (int i = 0; i < 16; ++i) acc[i] = 0.f;
#pragma unroll 8
    for (int kk = 0; kk < KS; kk += 2) {
        float a = in[(size_t)r * ldin + k0 + kk + hh]; if (SILU) a = a / (1.0f + __expf(-a));
        const float w = W[(size_t)(k0 + kk + hh) * N + n0 + r];
        acc = __builtin_amdgcn_mfma_f32_32x32x2f32(a, w, acc, 0, 0, 0);
    }
    const float bv = (bias && k0 == 0) ? bias[n0 + r] : 0.f;
#pragma unroll
    for (int i = 0; i < 16; ++i) { const int brow = (i & 3) + 8 * (i >> 2) + 4 * hh; atomicAdd(out + (size_t)brow * ldout + n0 + r, acc[i] + bv); }
}
__device__ __forceinline__ void sincos_d(double ang, float& sn, float& cs) {
    const double k = rint(ang * 0.63661977236758134308);
    const double t = (ang - k * 1.57079632679489655800) - k * 6.12323399573676603587e-17, t2 = t * t;
    double s = -1.0 / 6227020800.0; s = s * t2 + 1.0 / 39916800.0; s = s * t2 - 1.0 / 362880.0; s = s * t2 + 1.0 / 5040.0; s = s * t2 - 1.0 / 120.0; s = s * t2 + 1.0 / 6.0; s = t - t * t2 * s;
    double c = 1.0 / 479001600.0; c = c * t2 - 1.0 / 3628800.0; c = c * t2 + 1.0 / 40320.0; c = c * t2 - 1.0 / 720.0; c = c * t2 + 1.0 / 24.0; c = c * t2 - 0.5; c = 1.0 + t2 * c;
    const int q = (int)((long long)k & 3);
    const double ss = (q == 0) ? s : (q == 1) ? c : (q == 2) ? -s : -c;
    const double cc = (q == 0) ? c : (q == 1) ? -s : (q == 2) ? -c : s;
    sn = (float)ss; cs = (float)cc;
}

struct Ptrs {
    const float *x, *c, *ln1w, *ln2w, *wada, *bada, *win, *gnw, *wmo, *wro, *wout, *wff1, *wff2, *fnw;
    float* out; unsigned char* ws;
};

__device__ __forceinline__ void phase0(Frame& F, const Ptrs& P) {
    const int gw = F.vcu * NWAVES + F.wave, NGW = F.G * NWAVES;
    for (int gt = gw * 64 + F.lane; gt < 2 * 2048 * 32; gt += NGW * 64) {
        const int tb = gt >> 16, pos = (gt >> 5) & 2047, f = gt & 31;
        const double e = (tb == 0) ? (double)f * (1.0 / 32.0) : (double)f * (1.0 / 31.0);
        const double inv = exp2(-e * 13.28771237954945);
        float sn, cs; sincos_d((double)pos * inv, sn, cs);
        float* tab = (float*)(P.ws + WS_ROPE) + (size_t)tb * 2048 * 64 + pos * 64;
        tab[f] = cs; tab[32 + f] = sn;
    }
    for (int it = gw; it < 8 * 192; it += NGW) { const int ks = it / 192, cg = it % 192;
        gemv32_item<true>(P.c, D, P.wada, NADA, P.bada, (float*)(P.ws + WS_ADA), NADA, ks * 128, 128, cg * 32, F.lane); }
    LAS float* scr = (LAS float*)(F.lds + RING_OFF + F.wave * 16384);
    constexpr int I_IN = (D / 64) * (NIN / 32), I_MO = (512 / 64) * (D / 32), I_RO = (D / 64) * (D / 32), I_OUT = I_RO, I_1 = (D / 64) * (FF / 32), I_2 = (FF / 64) * (D / 32);
    constexpr int NITEMS = I_IN + I_MO + I_RO + I_OUT + I_1 + I_2;
    for (int it = gw; it < NITEMS; it += NGW) {
        int r = it;
        if (r < I_IN) { p0_transpose_item<true>(P.win, D, NIN, (bf16*)(P.ws + WS_WIN), scr, r, F.lane); continue; } r -= I_IN;
        if (r < I_MO) { p0_transpose_item<false>(P.wmo, 512, D, (bf16*)(P.ws + WS_WMO), scr, r, F.lane); continue; } r -= I_MO;
        if (r < I_RO) { p0_transpose_item<false>(P.wro, D, D, (bf16*)(P.ws + WS_WRO), scr, r, F.lane); continue; } r -= I_RO;
        if (r < I_OUT) { p0_transpose_item<false>(P.wout, D, D, (bf16*)(P.ws + WS_WOUT), scr, r, F.lane); continue; } r -= I_OUT;
        if (r < I_1) { p0_transpose_item<false>(P.wff1, D, FF, (bf16*)(P.ws + WS_W1), scr, r, F.lane); continue; } r -= I_1;
        p0_transpose_item<false>(P.wff2, FF, D, (bf16*)(P.ws + WS_W2), scr, r, F.lane);
    }
}
__device__ __forceinline__ void phase1(Frame& F, const Ptrs& P) {
    const int gw = F.vcu * NWAVES + F.wave, NGW = F.G * NWAVES;
    const float* ada = (const float*)(P.ws + WS_ADA);
    for (int it = gw; it < 8 * 128; it += NGW) { const int ks = it / 128, cg = it % 128;
        gemv32_item<false>(ada + 3 * D, NADA, P.wff1, FF, nullptr, (float*)(P.ws + WS_C1), FF, ks * 128, 128, cg * 32, F.lane); }
    bf16* H = (bf16*)(P.ws + WS_H);
    for (int r0 = gw * 32; r0 < M; r0 += NGW * 32) {
        const int b = r0 >> 11;
        f32x4 we[4], sh[4];
#pragma unroll
        for (int j = 0; j < 4; ++j) { const int c = 4 * F.lane + 256 * j; const f32x4 w = *(const f32x4*)(P.ln1w + c), s = *(const f32x4*)(ada + (size_t)b * NADA + D + c);
            we[j] = w * (s + 1.0f); sh[j] = *(const f32x4*)(ada + (size_t)b * NADA + c); }
        for (int rr = 0; rr < 32; rr += 2) {
            f32x4 v[2][4]; float s2[2] = {0.f, 0.f};
#pragma unroll
            for (int q = 0; q < 2; ++q) { const GAS f32x4* xr = (const GAS f32x4*)(P.x + (size_t)(r0 + rr + q) * D) + F.lane;
#pragma unroll
                for (int j = 0; j < 4; ++j) v[q][j] = xr[64 * j]; }
#pragma unroll
            for (int q = 0; q < 2; ++q) {
#pragma unroll
                for (int j = 0; j < 4; ++j) s2[q] += (v[q][j].x * v[q][j].x + v[q][j].y * v[q][j].y) + (v[q][j].z * v[q][j].z + v[q][j].w * v[q][j].w);
                const float rstd = 1.0f / sqrtf(wave_sum(s2[q]) * (1.0f / D) + EPSN);
                GAS unsigned long long* o8 = (GAS unsigned long long*)(H + (size_t)(r0 + rr + q) * D) + F.lane;
#pragma unroll
                for (int j = 0; j < 4; ++j) { const f32x4 y = v[q][j] * rstd * we[j] + sh[j];
                    o8[64 * j] = (unsigned long long)pk2(y.x, y.y) | ((unsigned long long)pk2(y.z, y.w) << 32); }
            }
        }
    }
}
__device__ __forceinline__ void phase8(Frame& F, const Ptrs& P) {
    const int gw = F.vcu * NWAVES + F.wave, NGW = F.G * NWAVES;
    const float* ss2 = (const float*)(P.ws + WS_SS2);
    f32x4 fw[4];
#pragma unroll
    for (int j = 0; j < 4; ++j) fw[j] = *(const f32x4*)(P.fnw + 4 * F.lane + 256 * j);
    for (int r0 = gw * 32; r0 < M; r0 += NGW * 32) {
        for (int rr = 0; rr < 32; rr += 2) {
            f32x4 v[2][4];
#pragma unroll
            for (int q = 0; q < 2; ++q) { const GAS f32x4* xr = (const GAS f32x4*)(P.out + (size_t)(r0 + rr + q) * D) + F.lane;
#pragma unroll
                for (int j = 0; j < 4; ++j) v[q][j] = xr[64 * j]; }
#pragma unroll
            for (int q = 0; q < 2; ++q) { const float rstd = 1.0f / sqrtf(ss2[r0 + rr + q] * (1.0f / D) + EPSN);
                GAS f32x4* xo = (GAS f32x4*)(P.out + (size_t)(r0 + rr + q) * D) + F.lane;
#pragma unroll
                for (int j = 0; j < 4; ++j) xo[64 * j] = v[q][j] * rstd * fw[j]; }
        }
    }
}

__device__ __forceinline__ void unpack8(const v4u w, float* f) {
    f[0] = __builtin_bit_cast(float, w.x << 16); f[1] = __builtin_bit_cast(float, w.x & 0xffff0000u); f[2] = __builtin_bit_cast(float, w.y << 16); f[3] = __builtin_bit_cast(float, w.y & 0xffff0000u);
    f[4] = __builtin_bit_cast(float, w.z << 16); f[5] = __builtin_bit_cast(float, w.z & 0xffff0000u); f[6] = __builtin_bit_cast(float, w.w << 16); f[7] = __builtin_bit_cast(float, w.w & 0xffff0000u);
}
__device__ __forceinline__ unsigned moba_select(const float (&g)[7], int qb) {
    unsigned sel = 0;
#pragma unroll
    for (int j = 0; j < 7; ++j) { int cnt = 0;
#pragma unroll
        for (int k = 0; k < 7; ++k) if (k != j) cnt += (k < qb) && ((g[k] > g[j]) || (g[k] == g[j] && k < j));
        if (j < qb && cnt < 3) sel |= 1u << j; }
    return sel;
}
__device__ void naive_moba(Frame& F, const Ptrs& P) {
    const bf16* MQ = (const bf16*)(P.ws + WS_MQ); const bf16* MK = (const bf16*)(P.ws + WS_MK); const bf16* MV = (const bf16*)(P.ws + WS_MV); bf16* O = (bf16*)(P.ws + WS_MQ);
    const float* ksum = (const float*)(P.ws + WS_KSUM);
    const int gt0 = (F.vcu * NWAVES + F.wave) * 64 + F.lane, NT = F.G * NWAVES * 64;
    for (int idx = gt0; idx < BATCH * 8 * SEQ; idx += NT) {
        const int s = idx & 2047, bh = idx >> 11, b = bh >> 3, h = bh & 7, qb = s >> 8; const size_t row = (size_t)b * SEQ + s;
        float q[64];
#pragma unroll
        for (int i = 0; i < 8; ++i) unpack8(*(const v4u*)(MQ + row * 512 + h * 64 + 8 * i), q + 8 * i);
        float g[7];
#pragma unroll
        for (int j = 0; j < 7; ++j) { float a = 0.f; if (j < qb) { const float* kp = ksum + (size_t)(b * 8 + j) * 512 + h * 64;
#pragma unroll
                for (int d = 0; d < 64; ++d) a += q[d] * kp[d]; } g[j] = a; }
        const unsigned sel = moba_select(g, qb);
        float mx = -INFINITY, l = 0.f; float o[64];
#pragma unroll
        for (int d = 0; d < 64; ++d) o[d] = 0.f;
        for (int it = 0; it <= qb; ++it) {
            const int j = (it == 0) ? qb : it - 1; if (it > 0 && !((sel >> j) & 1u)) continue;
            const int nk = (it == 0) ? (s & 255) + 1 : 256;
#pragma unroll 1
            for (int k = 0; k < nk; ++k) {
                const size_t kr = (size_t)b * SEQ + j * 256 + k; float a = 0.f;
#pragma unroll
                for (int c = 0; c < 8; ++c) { float kf[8]; unpack8(*(const v4u*)(MK + kr * 512 + h * 64 + 8 * c), kf);
#pragma unroll
                    for (int d = 0; d < 8; ++d) a += q[8 * c + d] * kf[d]; }
                if (a > mx) { const float f = __builtin_amdgcn_exp2f(mx - a); mx = a; l *= f;
#pragma unroll
                    for (int d = 0; d < 64; ++d) o[d] *= f; }
                const float p = __builtin_amdgcn_exp2f(a - mx); l += p;
#pragma unroll
                for (int c = 0; c < 8; ++c) { float vf[8]; unpack8(*(const v4u*)(MV + kr * 512 + h * 64 + 8 * c), vf);
#pragma unroll
                    for (int d = 0; d < 8; ++d) o[8 * c + d] += p * vf[d]; }
            }
        }
        const float rl = 1.0f / l;
#pragma unroll
        for (int i = 0; i < 8; ++i) { v4u w; w.x = pk2(o[8 * i] * rl, o[8 * i + 1] * rl); w.y = pk2(o[8 * i + 2] * rl, o[8 * i + 3] * rl); w.z = pk2(o[8 * i + 4] * rl, o[8 * i + 5] * rl); w.w = pk2(o[8 * i + 6] * rl, o[8 * i + 7] * rl);
            *(v4u*)(O + row * 512 + h * 64 + 8 * i) = w; }
    }
}
__device__ void naive_ret(Frame& F, const Ptrs& P) {
    const bf16* RQ = (const bf16*)(P.ws + WS_RQ); const bf16* RK = (const bf16*)(P.ws + WS_RK); const bf16* RV = (const bf16*)(P.ws + WS_RV); bf16* RG = (bf16*)(P.ws + WS_RG);
    LAS float* Qs = (LAS float*)(F.lds + RING_OFF); LAS float* Ks = Qs + 1024; LAS float* Vs = Ks + 1024; LAS float* Pt = Vs + 2048;
    const int t = F.tid, e = t & 127, grp = t >> 7, d0 = grp * 16;
    for (int u = F.vcu; u < BATCH * 8; u += F.G) {
        const int b = u >> 3, h = u & 7; const float gam = 1.0f - exp2f(-5.0f - (float)h);
        float S[16];
#pragma unroll
        for (int d = 0; d < 16; ++d) S[d] = 0.f;
        __syncthreads();
        for (int tb = 0; tb < SEQ / 16; ++tb) {
            const size_t rbase = (size_t)b * SEQ + tb * 16;
            { const int idx = 2 * t, tok = idx >> 6, d = idx & 63;
              const unsigned wq = *(const unsigned*)(RQ + (rbase + tok) * 512 + h * 64 + d), wk = *(const unsigned*)(RK + (rbase + tok) * 512 + h * 64 + d);
              Qs[idx] = __builtin_bit_cast(float, wq << 16); Qs[idx + 1] = __builtin_bit_cast(float, wq & 0xffff0000u);
              Ks[idx] = __builtin_bit_cast(float, wk << 16); Ks[idx + 1] = __builtin_bit_cast(float, wk & 0xffff0000u);
              const int iv = 4 * t, tv = iv >> 7, ev = iv & 127; const unsigned long long wv = *(const unsigned long long*)(RV + (rbase + tv) * 1024 + h * 128 + ev);
              const unsigned w0 = (unsigned)wv, w1 = (unsigned)(wv >> 32);
              Vs[iv] = __builtin_bit_cast(float, w0 << 16); Vs[iv + 1] = __builtin_bit_cast(float, w0 & 0xffff0000u); Vs[iv + 2] = __builtin_bit_cast(float, w1 << 16); Vs[iv + 3] = __builtin_bit_cast(float, w1 & 0xffff0000u); }
            __syncthreads();
            for (int tok = 0; tok < 16; ++tok) { const float v = Vs[tok * 128 + e]; float a = 0.f;
#pragma unroll
                for (int d = 0; d < 16; ++d) { S[d] = gam * S[d] + Ks[tok * 64 + d0 + d] * v; a += Qs[tok * 64 + d0 + d] * S[d]; }
                Pt[(tok * 4 + grp) * 128 + e] = a; }
            __syncthreads();
#pragma unroll
            for (int q = 0; q < 2; ++q) { const int tok = 2 * F.wave + q; const size_t row = rbase + tok;
                float o0 = 0.f, o1 = 0.f;
#pragma unroll
                for (int gI = 0; gI < 4; ++gI) { o0 += Pt[(tok * 4 + gI) * 128 + F.lane]; o1 += Pt[(tok * 4 + gI) * 128 + 64 + F.lane]; }
                const float mu = wave_sum(o0 + o1) * (1.0f / 128.0f); const float a0 = o0 - mu, a1 = o1 - mu;
                const float var = wave_sum(a0 * a0 + a1 * a1) * (1.0f / 128.0f); const float rs = 1.0f / sqrtf(var + EPSN);
                bf16* gp = RG + row * 1024 + h * 128;
                const float g0 = __builtin_bit_cast(float, (unsigned)gp[F.lane] << 16), g1 = __builtin_bit_cast(float, (unsigned)gp[64 + F.lane] << 16);
                gp[F.lane] = (bf16)f2bf(a0 * rs * P.gnw[h * 128 + F.lane] * g0); gp[64 + F.lane] = (bf16)f2bf(a1 * rs * P.gnw[h * 128 + 64 + F.lane] * g1); }
        }
    }
}

#ifndef MK_N_LAUNCHES
#define MK_N_LAUNCHES 1
#endif
#ifndef FAST_ATTN
#define FAST_ATTN 0
#endif
#ifndef FAST_RET
#define FAST_RET 0
#endif
constexpr int N_PHASES = 9;
struct Args { const float* in[14]; float* out; unsigned char* ws; int ph_lo, ph_hi; };
__global__ void __launch_bounds__(NWAVES * 64, 2) fwd(Args args) {
    extern __shared__ __attribute__((aligned(16))) unsigned char lds[];
    Frame F;
    F.lds = (LAS unsigned char*)lds;
    F.MISC = (volatile LAS unsigned*)(F.lds + MISC_OFF);
    F.tid = threadIdx.x; F.lane = F.tid & 63; F.wave = __builtin_amdgcn_readfirstlane(F.tid >> 6);
    F.G = gridDim.x; { const int bx = blockIdx.x; F.vcu = (F.G % 8 == 0) ? (bx % 8) * (F.G / 8) + bx / 8 : bx; }
    Ptrs P;
    P.x = args.in[0]; P.c = args.in[1]; P.ln1w = args.in[2]; P.ln2w = args.in[3]; P.wada = args.in[4]; P.bada = args.in[5]; P.win = args.in[6]; P.gnw = args.in[7];
    P.wmo = args.in[8]; P.wro = args.in[9]; P.wout = args.in[10]; P.wff1 = args.in[11]; P.wff2 = args.in[12]; P.fnw = args.in[13]; P.out = args.out; P.ws = args.ws;
    unsigned char* ws = args.ws;
    for (int u = F.tid; u < (LDS_BYTES - LDSCTL_OFF) / 4; u += NWAVES * 64) ((LAS unsigned*)(F.lds + LDSCTL_OFF))[u] = 0u;
    __syncthreads();
    const int lo = args.ph_lo, hi = args.ph_hi;
    XcdBarrier bar; bar.bar = (unsigned*)(ws + WS_CTL) + CW_BAR; bar.x = 0; bar.st = nullptr;
    if (hi - lo > 1) bar = xcd_barrier_post((unsigned*)(ws + WS_CTL) + CW_BAR, F.MISC + 8);
#ifndef PH_MASK
#define PH_MASK 0x1ff
#endif
#define IN(k) (((PH_MASK >> (k)) & 1) && lo <= (k) && (k) < hi)
#define SEAM(k) do { if (IN(k) && IN((k) + 1)) xcd_barrier(bar); } while (0)
    typedef pg8::bf16_t pb;
    const float* ada = (const float*)(ws + WS_ADA);

    if (IN(0)) { phase0(F, P); SEAM(0); }
    if (IN(1)) { phase1(F, P); SEAM(1); }
    if (IN(2)) {
        pg8::Gemm g{(const pb*)(ws + WS_H), (const pb*)(ws + WS_WIN), M, NIN, D}; pg8::StaticOrder S; S.init(M, NIN, F.G, (int)blockIdx.x);
        pg8::EpiIn E{(pb*)(ws + WS_MQ), (pb*)(ws + WS_MK), (pb*)(ws + WS_MV), (pb*)(ws + WS_RQ), (pb*)(ws + WS_RK), (pb*)(ws + WS_RV), (pb*)(ws + WS_RG), (pb*)(ws + WS_SGA), (pb*)(ws + WS_SGR),
                     (const float*)(ws + WS_ROPE), (const float*)(ws + WS_ROPE) + 2048 * 64, (float*)(ws + WS_KSUM), QSCALE};
        pg8::gemm_phase<pg8::EpiIn, pg8::StaticOrder, true, true>(F.lds + RING_OFF, g, S, E);
        SEAM(2);
    }
    if (IN(3)) {
        naive_moba(F, P);
        naive_ret(F, P);
        SEAM(3);
    }
    if (IN(4)) {
        { pg8::Gemm g{(const pb*)(ws + WS_MQ), (const pb*)(ws + WS_WMO), M, D, 512}; pg8::StaticOrder S; S.init(M, D, F.G, (int)blockIdx.x);
          pg8::EpiMerge<false> E{(const pb*)(ws + WS_SGA), (pb*)(ws + WS_H)};
          pg8::gemm_phase<pg8::EpiMerge<false>, pg8::StaticOrder, true, true>(F.lds + RING_OFF, g, S, E); }
        { pg8::Gemm g{(const pb*)(ws + WS_RG), (const pb*)(ws + WS_WRO), M, D, D}; pg8::StaticOrder S; S.init(M, D, F.G, (int)blockIdx.x);
          pg8::EpiMerge<true> E{(const pb*)(ws + WS_SGR), (pb*)(ws + WS_H)};
          pg8::gemm_phase<pg8::EpiMerge<true>, pg8::StaticOrder, true, true>(F.lds + RING_OFF, g, S, E); }
        SEAM(4);
    }
    if (IN(5)) {
        pg8::Gemm g{(const pb*)(ws + WS_H), (const pb*)(ws + WS_WOUT), M, D, D}; pg8::StaticOrder S; S.init(M, D, F.G, (int)blockIdx.x);
        pg8::EpiRes E{P.x, P.out, ada + 2 * D, P.ln2w, ada + 4 * D, (pb*)(ws + WS_A2), (float*)(ws + WS_SS1)};
        pg8::gemm_phase<pg8::EpiRes, pg8::StaticOrder, true, true>(F.lds + RING_OFF, g, S, E);
        SEAM(5);
    }
    if (IN(6)) {
        pg8::Gemm g{(const pb*)(ws + WS_A2), (const pb*)(ws + WS_W1), M, FF, D}; pg8::StaticOrder S; S.init(M, FF, F.G, (int)blockIdx.x);
        pg8::EpiFF1 E{(pb*)(ws + WS_ACT), (const float*)(ws + WS_C1), (const float*)(ws + WS_SS1), EPSN};
        pg8::gemm_phase<pg8::EpiFF1, pg8::StaticOrder, true, true>(F.lds + RING_OFF, g, S, E);
        SEAM(6);
    }
    if (IN(7)) {
        pg8::Gemm g{(const pb*)(ws + WS_ACT), (const pb*)(ws + WS_W2), M, D, FF}; pg8::StaticOrder S; S.init(M, D, F.G, (int)blockIdx.x);
        pg8::EpiRes E{P.out, P.out, ada + 5 * D, nullptr, nullptr, nullptr, (float*)(ws + WS_SS2)};
        pg8::gemm_phase<pg8::EpiRes, pg8::StaticOrder, true, true>(F.lds + RING_OFF, g, S, E);
        SEAM(7);
    }
    if (IN(8)) { phase8(F, P); }
#undef IN
#undef SEAM
}

extern "C" void kernel_launch(void* const* d_in, const int* in_sizes, int n_in, void* d_out, int out_size, void* d_ws, size_t ws_size, hipStream_t stream) {
    static int grid = 0;
    if (grid == 0) {
        if (n_in != 14 || in_sizes[0] != M * D || out_size != M * D || ws_size < WS_END) { fprintf(stderr, "kernel_launch: shape/workspace mismatch: n_in %d in0 %d out %d ws %zu (need %zu)\n", n_in, n_in > 0 ? in_sizes[0] : -1, out_size, ws_size, (size_t)WS_END); grid = -1; return; }
        int dev = 0, cus = 0, per_cu = 0;
        if (hipGetDevice(&dev) != hipSuccess || hipDeviceGetAttribute(&cus, hipDeviceAttributeMultiprocessorCount, dev) != hipSuccess) { grid = -1; return; }
        if (hipFuncSetAttribute((const void*)fwd, hipFuncAttributeMaxDynamicSharedMemorySize, LDS_BYTES) != hipSuccess) { fprintf(stderr, "kernel_launch: hipFuncSetAttribute failed\n"); grid = -1; return; }
        if (hipOccupancyMaxActiveBlocksPerMultiprocessor(&per_cu, (const void*)fwd, NWAVES * 64, LDS_BYTES) != hipSuccess || per_cu < 1) { fprintf(stderr, "kernel_launch: occupancy query says %d blocks per CU\n", per_cu); }
        (void)hipGetLastError();
        grid = cus;
    }
    if (grid < 0) return;
    if (hipMemsetAsync((char*)d_ws + WS_CTL, 0, ZERO_BYTES, stream) != hipSuccess) { fprintf(stderr, "kernel_launch: memset failed\n"); return; }
    Args a{};
    for (int i = 0; i < 14; ++i) a.in[i] = (const float*)d_in[i];
    a.out = (float*)d_out; a.ws = (unsigned char*)d_ws;
    if (MK_N_LAUNCHES == 1) { a.ph_lo = 0; a.ph_hi = N_PHASES; hipLaunchKernelGGL(fwd, dim3(grid), dim3(NWAVES * 64), LDS_BYTES, stream, a); }
    else for (int li = 0; li < N_PHASES; ++li) { a.ph_lo = li; a.ph_hi = li + 1; hipLaunchKernelGGL(fwd, dim3(grid), dim3(NWAVES * 64), LDS_BYTES, stream, a); }
    const hipError_t le = hipPeekAtLastError();
    if (le != hipSuccess) fprintf(stderr, "kernel_launch: launch failed: %s\n", hipGetErrorName(le));
}
```

```cpp
#include <hip/hip_runtime.h>
#include <cstdio>
#include <cstdint>
#include <cmath>
namespace pg8 {
#define PG8_LAS __attribute__((address_space(3)))
typedef unsigned short bf16_t;
typedef short bf16x8 __attribute__((ext_vector_type(8)));
typedef float f32x4 __attribute__((ext_vector_type(4)));
typedef unsigned u32x4 __attribute__((ext_vector_type(4)));
constexpr int BM = 256, BK = 64, HALF = 128, HTB = HALF * BK * 2  , STAGE_BYTES = 8 * HTB, NXCD = 8, WGM = 8;

__host__ __device__ __forceinline__ int lds_byte(int r, int c) { const int st = (r >> 4) * 2 + (c >> 5), rr = r & 15, cc = c & 31, ob = rr * 64 + cc * 2; return st * 1024 + (ob ^ (((ob >> 9) & 1) << 5)); }
__host__ __device__ __forceinline__ void stage_rc(int b, int& R, int& C) { const int st = b / 1024, sb = b % 1024, swz = sb ^ (((sb >> 9) & 1) << 5); R = (st >> 1) * 16 + swz / 64; C = (st & 1) * 32 + (swz % 64) / 2; }
__host__ __device__ __forceinline__ int perm32(int rho) { const int n = rho >> 4, i = rho & 15; return 8 * (i >> 2) + 4 * n + (i & 3); }

struct Unit { int pm, pn; };
struct Gemm { const bf16_t* A; const bf16_t* Bt; int M, N, K; };

struct StaticOrder {
    int nM, nN, nwg, G, c;
    __host__ __device__ void init(int M, int N, int G_, int c_) { nM = M / BM; nN = N / BM; nwg = nM * nN; G = G_; c = c_; }
    __host__ __device__ bool next(int i, Unit& u) const {
        const long L = (long)i * G + c; if (L >= nwg) return false;
        int wgid = (int)L; { const int q = nwg / NXCD, r = nwg % NXCD, xcd = wgid % NXCD, off = wgid / NXCD; wgid = (xcd < r ? xcd * (q + 1) : r * (q + 1) + (xcd - r) * q) + off; }
        const int nig = WGM * nN, gid = wgid / nig, fm = gid * WGM, gsz = (nM - fm) < WGM ? (nM - fm) : WGM;
        u.pm = fm + ((wgid % nig) % gsz); u.pn = (wgid % nig) / gsz; return true;
    }
    __device__ __forceinline__ void a_ready(const Unit&) const {}
    __device__ __forceinline__ void done(const Unit&) const {}
};

__device__ __forceinline__ unsigned cvt_pk_bf16(float lo, float hi) { unsigned r; asm volatile("v_cvt_pk_bf16_f32 %0, %1, %2" : "=v"(r) : "v"(lo), "v"(hi)); return r; }
typedef float f32x2 __attribute__((ext_vector_type(2)));
typedef unsigned u32x2 __attribute__((ext_vector_type(2)));
__device__ __forceinline__ float sigm(float x) { return __builtin_amdgcn_rcpf(1.f + __builtin_amdgcn_exp2f(-1.4426950408889634f * x)); }
__device__ __forceinline__ float bf_lo(unsigned w) { return __builtin_bit_cast(float, w << 16); }
__device__ __forceinline__ float bf_hi(unsigned w) { return __builtin_bit_cast(float, w & 0xffff0000u); }
__device__ __forceinline__ u32x4 pack8(f32x4 a, f32x4 b) { u32x4 w; w.x = cvt_pk_bf16(a[0], a[1]); w.y = cvt_pk_bf16(a[2], a[3]); w.z = cvt_pk_bf16(b[0], b[1]); w.w = cvt_pk_bf16(b[2], b[3]); return w; }

struct EpiIn {
    static constexpr bool PERM = true, AFTER_DRAIN = false;
    bf16_t *MQ, *MK, *MV, *RQ, *RK, *RV, *RG, *SGA, *SGR; const float* rope_moba; const float* rope_ret; float* ksum; float qscale;
    __device__ __forceinline__ void operator()(const f32x4 (&acc)[2][2][4][2], const Unit& u, int wr, int wc, int fr, int fq) const {
        const int pn = u.pn; const int row0 = u.pm * BM + wr * 64 + fr;
        bf16_t* base; int ldc, colt, mode; float sc = 1.f; const float* tab = rope_moba;
        if (pn < 2)       { base = MQ;  ldc = 512;  colt = pn * 256;        mode = 1; sc = qscale; }
        else if (pn < 4)  { base = MK;  ldc = 512;  colt = (pn - 2) * 256;  mode = 1; }
        else if (pn < 6)  { base = MV;  ldc = 512;  colt = (pn - 4) * 256;  mode = 0; }
        else if (pn < 8)  { base = RQ;  ldc = 512;  colt = (pn - 6) * 256;  mode = 1; tab = rope_ret; }
        else if (pn < 10) { base = RK;  ldc = 512;  colt = (pn - 8) * 256;  mode = 1; tab = rope_ret; sc = 0.125f; }
        else if (pn < 14) { base = RV;  ldc = 1024; colt = (pn - 10) * 256; mode = 0; }
        else if (pn < 18) { base = RG;  ldc = 1024; colt = (pn - 14) * 256; mode = 2; }
        else if (pn < 22) { base = SGA; ldc = 1024; colt = (pn - 18) * 256; mode = 3; }
        else              { base = SGR; ldc = 1024; colt = (pn - 22) * 256; mode = 3; }
        const int col0 = colt + wc * 32 + 8 * fq;
        if (mode == 1) {
            const int g = 4 * (wc & 1) + fq; const bool isk = (pn == 2 || pn == 3);
            f32x4 ks[2][2];
#pragma unroll
            for (int bj = 0; bj < 2; ++bj)
#pragma unroll
                for (int n = 0; n < 2; ++n) ks[bj][n] = (f32x4){0.f, 0.f, 0.f, 0.f};
#pragma unroll
            for (int ai = 0; ai < 2; ++ai)
#pragma unroll
                for (int m = 0; m < 4; ++m) {
                    const int row = row0 + ai * HALF + m * 16; const int pos = row & 2047;
                    const f32x4 cs = *(const f32x4*)(tab + pos * 64 + 4 * g), sn = *(const f32x4*)(tab + pos * 64 + 32 + 4 * g);
                    bf16_t* rowp = base + (size_t)row * ldc + col0;
#pragma unroll
                    for (int bj = 0; bj < 2; ++bj) {
                        const f32x4 v0 = acc[ai][bj][m][0], v1 = acc[ai][bj][m][1];
                        const f32x4 o0 = (v0 * cs - v1 * sn) * sc, o1 = (v0 * sn + v1 * cs) * sc;
                        if (isk) { ks[bj][0] += o0; ks[bj][1] += o1; }
                        *(u32x4*)(rowp + bj * HALF) = pack8(o0, o1);
                    }
                }
            if (isk) {
#pragma unroll
                for (int bj = 0; bj < 2; ++bj)
#pragma unroll
                    for (int n = 0; n < 2; ++n)
#pragma unroll
                        for (int e = 0; e < 4; ++e) { float s = ks[bj][n][e]; s += __shfl_xor(s, 1); s += __shfl_xor(s, 2); s += __shfl_xor(s, 4); s += __shfl_xor(s, 8);
                            if (fr == 0) atomicAdd(ksum + (size_t)u.pm * 512 + col0 + bj * HALF + 4 * n + e, s); }
            }
        } else {
#pragma unroll
            for (int ai = 0; ai < 2; ++ai)
#pragma unroll
                for (int m = 0; m < 4; ++m) {
                    bf16_t* rowp = base + (size_t)(row0 + ai * HALF + m * 16) * ldc + col0;
#pragma unroll
                    for (int bj = 0; bj < 2; ++bj) {
                        f32x4 v0 = acc[ai][bj][m][0], v1 = acc[ai][bj][m][1];
                        if (mode >= 2) {
#pragma unroll
                            for (int e = 0; e < 4; ++e) { const float s0 = sigm(v0[e]), s1 = sigm(v1[e]); v0[e] = (mode == 2) ? v0[e] * s0 : s0; v1[e] = (mode == 2) ? v1[e] * s1 : s1; }
                        }
                        *(u32x4*)(rowp + bj * HALF) = pack8(v0, v1);
                    }
                }
        }
    }
};

template <bool ADD> struct EpiMerge {
    static constexpr bool PERM = true, AFTER_DRAIN = false;
    const bf16_t* gate; bf16_t* out;
    __device__ __forceinline__ void operator()(const f32x4 (&acc)[2][2][4][2], const Unit& u, int wr, int wc, int fr, int fq) const {
        const int row0 = u.pm * BM + wr * 64 + fr, col0 = u.pn * BM + wc * 32 + 8 * fq;
#pragma unroll
        for (int ai = 0; ai < 2; ++ai)
#pragma unroll
            for (int m = 0; m < 4; ++m) {
                const size_t off = (size_t)(row0 + ai * HALF + m * 16) * 1024 + col0;
#pragma unroll
                for (int bj = 0; bj < 2; ++bj) {
                    const u32x4 gw = *(const u32x4*)(gate + off + bj * HALF);
                    f32x4 v0 = acc[ai][bj][m][0], v1 = acc[ai][bj][m][1];
                    v0[0] *= bf_lo(gw.x); v0[1] *= bf_hi(gw.x); v0[2] *= bf_lo(gw.y); v0[3] *= bf_hi(gw.y);
                    v1[0] *= bf_lo(gw.z); v1[1] *= bf_hi(gw.z); v1[2] *= bf_lo(gw.w); v1[3] *= bf_hi(gw.w);
                    if (ADD) { const u32x4 pw = *(const u32x4*)(out + off + bj * HALF);
                        v0[0] += bf_lo(pw.x); v0[1] += bf_hi(pw.x); v0[2] += bf_lo(pw.y); v0[3] += bf_hi(pw.y);
                        v1[0] += bf_lo(pw.z); v1[1] += bf_hi(pw.z); v1[2] += bf_lo(pw.w); v1[3] += bf_hi(pw.w); }
                    *(u32x4*)(out + off + bj * HALF) = pack8(v0, v1);
                }
            }
    }
};

struct EpiRes {
    static constexpr bool PERM = false, AFTER_DRAIN = false;
    const float* xin; float* xo; const float* gvec  ; const float* lnw; const float* scv  ; bf16_t* A2; float* ss;
    __device__ __forceinline__ void operator()(const f32x4 (&acc)[2][2][4][2], const Unit& u, int wr, int wc, int fr, int fq) const {
        const int row0 = u.pm * BM + wr * 64 + fr, col0 = u.pn * BM + wc * 32 + 4 * fq; const int b = u.pm >> 3;
        f32x4 gv[2][2], we[2][2];
#pragma unroll
        for (int bj = 0; bj < 2; ++bj)
#pragma unroll
            for (int n = 0; n < 2; ++n) { const int c = col0 + bj * HALF + n * 16; gv[bj][n] = *(const f32x4*)(gvec + (size_t)b * 6144 + c);
                if (A2) { const f32x4 w = *(const f32x4*)(lnw + c), s = *(const f32x4*)(scv + (size_t)b * 6144 + c); we[bj][n] = w * (s + 1.0f); } else we[bj][n] = (f32x4){0.f, 0.f, 0.f, 0.f}; }
#pragma unroll
        for (int ai = 0; ai < 2; ++ai)
#pragma unroll
            for (int m = 0; m < 4; ++m) {
                const int row = row0 + ai * HALF + m * 16; const size_t off = (size_t)row * 1024 + col0; float q = 0.f;
#pragma unroll
                for (int bj = 0; bj < 2; ++bj)
#pragma unroll
                    for (int n = 0; n < 2; ++n) { const size_t o = off + bj * HALF + n * 16; const f32x4 xv = *(const f32x4*)(xin + o);
                        const f32x4 x1 = xv + gv[bj][n] * acc[ai][bj][m][n]; *(f32x4*)(xo + o) = x1; q += (x1[0] * x1[0] + x1[1] * x1[1]) + (x1[2] * x1[2] + x1[3] * x1[3]);
                        if (A2) { const f32x4 a = x1 * we[bj][n]; u32x2 w; w.x = cvt_pk_bf16(a[0], a[1]); w.y = cvt_pk_bf16(a[2], a[3]); *(u32x2*)(A2 + o) = w; } }
                q += __shfl_xor(q, 16); q += __shfl_xor(q, 32);
                if (fq == 0) atomicAdd(ss + row, q);
            }
    }
};

struct EpiFF1 {
    static constexpr bool PERM = true, AFTER_DRAIN = false;
    bf16_t* O; const float* c1; const float* ss; float eps;
    __device__ __forceinline__ void operator()(const f32x4 (&acc)[2][2][4][2], const Unit& u, int wr, int wc, int fr, int fq) const {
        const int row0 = u.pm * BM + wr * 64 + fr, col0 = u.pn * BM + wc * 32 + 8 * fq; const int b = u.pm >> 3;
        f32x4 cv[2][2];
#pragma unroll
        for (int bj = 0; bj < 2; ++bj)
#pragma unroll
            for (int n = 0; n < 2; ++n) cv[bj][n] = *(const f32x4*)(c1 + (size_t)b * 4096 + col0 + bj * HALF + 4 * n);
#pragma unroll
        for (int ai = 0; ai < 2; ++ai)
#pragma unroll
            for (int m = 0; m < 4; ++m) {
                const int row = row0 + ai * HALF + m * 16; const float rs = 1.0f / sqrtf(ss[row] * (1.0f / 1024.0f) + eps);
                bf16_t* rowp = O + (size_t)row * 4096 + col0;
#pragma unroll
                for (int bj = 0; bj < 2; ++bj) {
                    f32x4 v0 = acc[ai][bj][m][0] * rs + cv[bj][0], v1 = acc[ai][bj][m][1] * rs + cv[bj][1];
#pragma unroll
                    for (int e = 0; e < 4; ++e) { const float a = fmaxf(v0[e], 0.f), c = fmaxf(v1[e], 0.f); v0[e] = a * a; v1[e] = c * c; }
                    *(u32x4*)(rowp + bj * HALF) = pack8(v0, v1);
                }
            }
    }
};
template <class Epi, class Sched, bool ALIGN_EPI = false, bool SP2 = false>
__device__ __forceinline__ void gemm_phase(PG8_LAS unsigned char* lds, const Gemm g, const Sched& S, const Epi& E) {
    const int tid = threadIdx.x, wid = __builtin_amdgcn_readfirstlane(tid >> 6), lane = tid & 63, wr = wid >> 2, wc = wid & 3, fr = lane & 15, fq = lane >> 4;
    const int K = g.K, nt = K / BK;
    unsigned voffA[2], voffB[2];
#pragma unroll
    for (int i = 0; i < 2; ++i) { int R, C; stage_rc(tid * 16 + i * 8192, R, C); const int Rb = Epi::PERM ? ((R & ~31) + perm32(R & 31)) : R;
        voffA[i] = (unsigned)(R * K + C) * 2u; voffB[i] = (unsigned)(Rb * K + C) * 2u; }
    const size_t kstep = (size_t)(BK * 2);
    const size_t hstep = (size_t)HALF * K * 2;
    const size_t tstep = 2 * hstep;
    const unsigned ldsw = (unsigned)wid * 1024u;
    const int aoff = lds_byte(wr * 64 + fr, fq * 8), boff = lds_byte(wc * 32 + fr, fq * 8);
#define PG8_SA(b, h) (((b) * 2 + (h)) * HTB)
#define PG8_SB(b, h) ((4 + (b) * 2 + (h)) * HTB)
#define PG8_STAGE(bufoff, gbase, voff) do { _Pragma("unroll") for (int _i = 0; _i < 2; ++_i) \
        __builtin_amdgcn_global_load_lds((const unsigned*)((const char*)(gbase) + (voff)[_i]), (PG8_LAS unsigned*)(lds + (bufoff) + ldsw + _i * 8192), 16, 0, 0); } while (0)
#define PG8_LDA(dst, b, h) do { _Pragma("unroll") for (int m = 0; m < 4; ++m) _Pragma("unroll") for (int k = 0; k < 2; ++k) dst[m][k] = *(const PG8_LAS bf16x8*)(lds + PG8_SA(b, h) + aoff + m * 2048 + k * 1024); } while (0)
#define PG8_LDB(dst, b, h) do { _Pragma("unroll") for (int n = 0; n < 2; ++n) _Pragma("unroll") for (int k = 0; k < 2; ++k) dst[n][k] = *(const PG8_LAS bf16x8*)(lds + PG8_SB(b, h) + boff + n * 2048 + k * 1024); } while (0)
#define PG8_MMA(ai, bj, At, Bt) do { __builtin_amdgcn_s_setprio(1); _Pragma("unroll") for (int m = 0; m < 4; ++m) _Pragma("unroll") for (int n = 0; n < 2; ++n) _Pragma("unroll") for (int k = 0; k < 2; ++k) \
        acc[ai][bj][m][n] = __builtin_amdgcn_mfma_f32_16x16x32_bf16(Bt[n][k], At[m][k], acc[ai][bj][m][n], 0, 0, 0); __builtin_amdgcn_s_setprio(0); } while (0)
#define PG8_WAIT_V(n) asm volatile("s_waitcnt vmcnt(" #n ")" ::: "memory")
#define PG8_WAIT_L(n) asm volatile("s_waitcnt lgkmcnt(" #n ")" ::: "memory")
#define PG8_BAR __builtin_amdgcn_s_barrier()
#define PG8_SCHED __builtin_amdgcn_sched_barrier(0)
    Unit cur, nxt; int ui = 0;
    if (!S.next(0, cur)) return;
    f32x4 acc[2][2][4][2];
#pragma unroll
    for (int a = 0; a < 2; ++a)
#pragma unroll
        for (int b = 0; b < 2; ++b)
#pragma unroll
            for (int m = 0; m < 4; ++m)
#pragma unroll
                for (int n = 0; n < 2; ++n) acc[a][b][m][n] = (f32x4){0.f, 0.f, 0.f, 0.f};
    bf16x8 At[4][2], B0[2][2], B1[2][2];
    const char* cA = (const char*)g.A + (size_t)cur.pm * tstep; const char* cB = (const char*)g.Bt + (size_t)cur.pn * tstep;
    S.a_ready(cur);
    if constexpr (SP2) {
        PG8_STAGE(PG8_SB(0, 0), cB, voffB); PG8_STAGE(PG8_SB(0, 1), cB + hstep, voffB); PG8_STAGE(PG8_SA(0, 0), cA, voffA); PG8_STAGE(PG8_SA(0, 1), cA + hstep, voffA);
        if (wr == 1) PG8_BAR;
        PG8_WAIT_V(2); PG8_BAR;
        PG8_STAGE(PG8_SB(1, 0), cB + kstep, voffB); PG8_STAGE(PG8_SA(1, 0), cA + kstep, voffA); PG8_STAGE(PG8_SB(1, 1), cB + hstep + kstep, voffB);
        PG8_WAIT_V(6); PG8_BAR;
    } else {
        PG8_STAGE(PG8_SB(0, 0), cB, voffB); PG8_STAGE(PG8_SA(0, 0), cA, voffA); PG8_STAGE(PG8_SB(0, 1), cB + hstep, voffB); PG8_STAGE(PG8_SA(0, 1), cA + hstep, voffA);
        if (wr == 1) PG8_BAR;
        PG8_WAIT_V(4); PG8_BAR;
        PG8_STAGE(PG8_SB(1, 0), cB + kstep, voffB); PG8_STAGE(PG8_SA(1, 0), cA + kstep, voffA); PG8_STAGE(PG8_SB(1, 1), cB + hstep + kstep, voffB);
        PG8_WAIT_V(6); PG8_BAR;
    }
    for (;;) {
        const bool has_next = S.next(ui + 1, nxt);
        const char* nA = has_next ? (const char*)g.A + (size_t)nxt.pm * tstep : cA; const char* nB = has_next ? (const char*)g.Bt + (size_t)nxt.pn * tstep : cB;
        for (int t = 0; t < nt; t += 2) {
            const bool last = (t == nt - 2);
            const char* a1 = cA + (size_t)(t + 1) * kstep;
            const char* a2 = last ? nA : cA + (size_t)(t + 2) * kstep; const char* b2 = last ? nB : cB + (size_t)(t + 2) * kstep;
            const char* a3 = a2 + kstep; const char* b3 = b2 + kstep;
            if (last && has_next) S.a_ready(nxt);
            if constexpr (SP2) {
            PG8_LDB(B0, 0, 0); PG8_LDB(B1, 0, 1); PG8_SCHED; PG8_LDA(At, 0, 0); PG8_STAGE(PG8_SA(1, 1), a1 + hstep, voffA);
            PG8_WAIT_V(8); PG8_WAIT_L(0); PG8_BAR; PG8_MMA(0, 0, At, B0); PG8_MMA(0, 1, At, B1); PG8_BAR; PG8_SCHED;
            PG8_LDA(At, 0, 1); PG8_STAGE(PG8_SB(0, 0), b2, voffB); PG8_STAGE(PG8_SB(0, 1), b2 + hstep, voffB); PG8_STAGE(PG8_SA(0, 0), a2, voffA);
            PG8_WAIT_V(8); PG8_WAIT_L(0); PG8_BAR; PG8_MMA(1, 0, At, B0); PG8_MMA(1, 1, At, B1); PG8_BAR; PG8_SCHED;
            PG8_LDB(B0, 1, 0); PG8_LDB(B1, 1, 1); PG8_SCHED; PG8_LDA(At, 1, 0); PG8_STAGE(PG8_SA(0, 1), a2 + hstep, voffA);
            PG8_WAIT_V(8); PG8_WAIT_L(0); PG8_BAR; PG8_MMA(0, 0, At, B0); PG8_MMA(0, 1, At, B1); PG8_BAR; PG8_SCHED;
            PG8_LDA(At, 1, 1); PG8_STAGE(PG8_SB(1, 0), b3, voffB); PG8_STAGE(PG8_SB(1, 1), b3 + hstep, voffB); PG8_STAGE(PG8_SA(1, 0), a3, voffA);
            PG8_WAIT_V(8); PG8_WAIT_L(0); PG8_BAR; PG8_MMA(1, 0, At, B0); PG8_MMA(1, 1, At, B1); PG8_BAR; PG8_SCHED;
            } else {
            PG8_LDB(B0, 0, 0); PG8_SCHED; PG8_LDA(At, 0, 0); PG8_STAGE(PG8_SA(1, 1), a1 + hstep, voffA);
            PG8_WAIT_L(8); PG8_BAR; PG8_WAIT_L(0); PG8_MMA(0, 0, At, B0); PG8_BAR; PG8_SCHED;
            PG8_LDB(B1, 0, 1); PG8_STAGE(PG8_SB(0, 0), b2, voffB);
            PG8_BAR; PG8_WAIT_L(0); PG8_MMA(0, 1, At, B1); PG8_BAR;
            PG8_LDA(At, 0, 1); PG8_STAGE(PG8_SA(0, 0), a2, voffA);
            PG8_BAR; PG8_WAIT_L(0); PG8_MMA(1, 0, At, B0); PG8_BAR; PG8_SCHED;
            PG8_STAGE(PG8_SB(0, 1), b2 + hstep, voffB);
            PG8_WAIT_V(6); PG8_BAR; PG8_MMA(1, 1, At, B1); PG8_BAR;
            PG8_LDB(B0, 1, 0); PG8_SCHED; PG8_LDA(At, 1, 0); PG8_STAGE(PG8_SA(0, 1), a2 + hstep, voffA);
            PG8_WAIT_L(8); PG8_BAR; PG8_WAIT_L(0); PG8_MMA(0, 0, At, B0); PG8_BAR; PG8_SCHED;
            PG8_LDB(B1, 1, 1); PG8_STAGE(PG8_SB(1, 0), b3, voffB);
            PG8_BAR; PG8_WAIT_L(0); PG8_MMA(0, 1, At, B1); PG8_BAR;
            PG8_LDA(At, 1, 1); PG8_STAGE(PG8_SA(1, 0), a3, voffA);
            PG8_BAR; PG8_WAIT_L(0); PG8_MMA(1, 0, At, B0); PG8_BAR; PG8_SCHED;
            PG8_STAGE(PG8_SB(1, 1), b3 + hstep, voffB);
            PG8_WAIT_V(6); PG8_BAR; PG8_MMA(1, 1, At, B1); PG8_BAR;
            }
        }
        if constexpr (ALIGN_EPI) { if (wr == 0) PG8_BAR; }
        if constexpr (!Epi::AFTER_DRAIN) { E(acc, cur, wr, wc, fr, fq); S.done(cur); }
        if (!has_next) break;
#pragma unroll
        for (int a = 0; a < 2; ++a)
#pragma unroll
            for (int b = 0; b < 2; ++b)
#pragma unroll
                for (int m = 0; m < 4; ++m)
#pragma unroll
                    for (int n = 0; n < 2; ++n) acc[a][b][m][n] = (f32x4){0.f, 0.f, 0.f, 0.f};
        cur = nxt; cA = nA; cB = nB; ++ui;
        if constexpr (ALIGN_EPI) { if (wr == 1) PG8_BAR; }
    }
    PG8_WAIT_V(0);
    if constexpr (!ALIGN_EPI) { if (wr == 0) PG8_BAR; }
    PG8_BAR;
    if constexpr (Epi::AFTER_DRAIN) { E.fused(acc, cur, wr, wc, fr, fq, lds, wid, lane); S.done(cur); }
#undef PG8_SA
#undef PG8_SB
#undef PG8_STAGE
#undef PG8_LDA
#undef PG8_LDB
#undef PG8_MMA
#undef PG8_WAIT_V
#undef PG8_WAIT_L
#undef PG8_BAR
#undef PG8_SCHED
}
}
#define GAS __attribute__((address_space(1)))
#define LAS __attribute__((address_space(3)))
typedef unsigned short bf16;
typedef unsigned v4u __attribute__((ext_vector_type(4)));
typedef float f32x4 __attribute__((ext_vector_type(4)));
typedef short bf16x8 __attribute__((ext_vector_type(8)));
typedef GAS unsigned gu32;
typedef GAS unsigned long long gu64;
#define RLX_AGENT __ATOMIC_RELAXED, __HIP_MEMORY_SCOPE_AGENT
#define LDS_WAIT() asm volatile("s_waitcnt lgkmcnt(0)" ::: "memory")
#define VM_WAIT() asm volatile("s_waitcnt vmcnt(0)" ::: "memory")
__device__ __forceinline__ unsigned long long rt() { return __builtin_amdgcn_s_memrealtime(); }
__device__ __forceinline__ unsigned f2bf(float f) { unsigned u = __builtin_bit_cast(unsigned, f); return (u + 0x7fffu + ((u >> 16) & 1u)) >> 16; }
__device__ __forceinline__ unsigned pk2(float lo, float hi) { return f2bf(lo) | (f2bf(hi) << 16); }

#define XB_TMO      128
#define XB_XCNT(j)  (256  + 64 * (j))
#define XB_XSUB(j)  (1280 + 64 * (j))
#define XB_XGEN(j)  (2304 + 64 * (j))
#define XB_TOP      3328
#define XB_TOPGEN   3392
#define XCD_BAR_WORDS 3456
#define XB_SPIN_CAP (1u << 18)

__device__ __forceinline__ unsigned xb_ld(unsigned* p)              { return __hip_atomic_load(p, __ATOMIC_RELAXED, __HIP_MEMORY_SCOPE_AGENT); }
__device__ __forceinline__ unsigned xb_add(unsigned* p, unsigned v) { return __hip_atomic_fetch_add(p, v, __ATOMIC_RELAXED, __HIP_MEMORY_SCOPE_AGENT); }
__device__ __forceinline__ unsigned xb_xcc_id() { return (unsigned)__builtin_amdgcn_s_getreg((3 << 11) | 20) & 0xFu; }
#define XB_SPIN(cond, bar) do { unsigned _sp = 0; while (cond) { __builtin_amdgcn_s_sleep(1); \
    if ((++_sp & 255u) == 0u) { if (xb_ld(&(bar)[XB_TMO])) break; if (_sp > XB_SPIN_CAP) { atomicAdd(&(bar)[XB_TMO], 1u); break; } } } } while (0)

struct XcdBarrier {
    unsigned* bar; unsigned x;
    volatile LAS unsigned* st;
};

__device__ __forceinline__ XcdBarrier xcd_barrier_post(unsigned* bar, volatile LAS unsigned* st) {
    XcdBarrier b; b.bar = bar; b.x = xb_xcc_id(); b.st = st;
    if (threadIdx.x == 0) (void)xb_add(&bar[XB_XCNT(b.x)], 1u);
    return b;
}
__device__ __forceinline__ void xcd_barrier_complete(unsigned* bar, unsigned x, unsigned& nloc, unsigned& nx) {
    const unsigned G = gridDim.x * gridDim.y * gridDim.z;
    unsigned sum, cnt, mine, sp = 0u;
    for (;;) {
        sum = 0u; cnt = 0u; mine = 0u;
#pragma unroll
        for (unsigned j = 0; j < 16; ++j) { const unsigned c = xb_ld(&bar[XB_XCNT(j)]); sum += c; cnt += (c > 0u) ? 1u : 0u; mine = (j == x) ? c : mine; }
        if (sum == G) break;
        __builtin_amdgcn_s_sleep(1);
        if ((++sp & 255u) == 0u) { if (xb_ld(&bar[XB_TMO])) break; if (sp > XB_SPIN_CAP) { atomicAdd(&bar[XB_TMO], 1u); break; } }
    }
    nloc = mine > 0u ? mine : 1u; nx = cnt > 0u ? cnt : 1u;
}

__device__ __forceinline__ void xcd_barrier(const XcdBarrier& b) {
    asm volatile("s_waitcnt vmcnt(0)" ::: "memory");
    __syncthreads();
    if (threadIdx.x == 0) {
        unsigned* bar = b.bar;
        __builtin_amdgcn_s_waitcnt(0);
        unsigned nloc = b.st[0], nx = b.st[1];
        if (nloc == 0u) { xcd_barrier_complete(bar, b.x, nloc, nx); b.st[0] = nloc; b.st[1] = nx; }
        const unsigned old = xb_add(&bar[XB_XSUB(b.x)], 1u);
        const unsigned gen = old / nloc;
        if (old + 1u == (gen + 1u) * nloc) {
            __builtin_amdgcn_fence(__ATOMIC_RELEASE, "agent");
            asm volatile("s_waitcnt vmcnt(0)" ::: "memory");
            const unsigned og = xb_add(&bar[XB_TOP], 1u);
            const unsigned tg = og / nx;
            if (og + 1u == (tg + 1u) * nx) xb_add(&bar[XB_TOPGEN], 1u);
            else XB_SPIN(xb_ld(&bar[XB_TOPGEN]) == tg, bar);
            __builtin_amdgcn_fence(__ATOMIC_ACQUIRE, "agent");
            xb_add(&bar[XB_XGEN(b.x)], 1u);
            asm volatile("s_waitcnt vmcnt(0)" ::: "memory");
        } else {
            XB_SPIN(xb_ld(&bar[XB_XGEN(b.x)]) == gen, bar);
            __builtin_amdgcn_fence(__ATOMIC_ACQUIRE, "agent");
            asm volatile("s_waitcnt vmcnt(0)" ::: "memory");
        }
    }
    __syncthreads();
}

constexpr int NWAVES = 8;
constexpr int BATCH = 32, SEQ = 2048, D = 1024, FF = 4096, NIN = 6656, NADA = 6144;
constexpr int M = BATCH * SEQ;
constexpr float EPSN = 1e-6f;
constexpr float QSCALE = 0.125f * 1.4426950408889634f;
constexpr size_t KiB = 1024, MiB = 1u << 20;
constexpr size_t WS_CTL = 0;
constexpr size_t WS_ADA = 64 * KiB;
constexpr size_t WS_C1 = 832 * KiB;
constexpr size_t WS_KSUM = 1344 * KiB;
constexpr size_t WS_SS1 = 1856 * KiB;
constexpr size_t WS_SS2 = 2112 * KiB;
constexpr size_t ZERO_BYTES = 2560 * KiB;
constexpr size_t WS_ROPE = 3 * MiB;
constexpr size_t WS_WIN = 8 * MiB, WS_WMO = 21 * MiB, WS_WRO = 22 * MiB, WS_WOUT = 24 * MiB, WS_W1 = 26 * MiB, WS_W2 = 34 * MiB;
constexpr size_t WS_H = 48 * MiB;
constexpr size_t WS_MQ = 176 * MiB, WS_MK = 240 * MiB, WS_MV = 304 * MiB, WS_RQ = 368 * MiB, WS_RK = 432 * MiB;
constexpr size_t WS_RV = 496 * MiB, WS_RG = 624 * MiB, WS_SGA = 752 * MiB, WS_SGR = 880 * MiB;
constexpr size_t WS_A2 = 240 * MiB;
constexpr size_t WS_ACT = 496 * MiB;
constexpr size_t WS_END = 1008 * MiB;
constexpr int CW_BAR = 4096;
constexpr int RING_OFF = 0, RING_BYTES = 131072;
constexpr int LDSCTL_OFF = RING_BYTES, MISC_OFF = LDSCTL_OFF + 320;
constexpr int LDS_BYTES = 147456;

struct Frame {
    LAS unsigned char* lds;
    volatile LAS unsigned* MISC;
    int tid, lane, wave, vcu, G;
};

__device__ __forceinline__ float wave_sum(float v) {
#pragma unroll
    for (int o = 1; o < 64; o <<= 1) v += __shfl_xor(v, o);
    return v;
}
__device__ __forceinline__ int win_dst_row(int n) {
    const bool qk = (n < 1024) || (n >= 1536 && n < 2560);
    if (!qk) return n;
    const int d = n & 63, s = d >> 5, i = d & 31;
    return (n & ~63) + 8 * (i >> 2) + 4 * s + (i & 3);
}
template <bool PERMUTE>
__device__ __forceinline__ void p0_transpose_item(const float* W, int K, int N, bf16* WT, LAS float* scr, int item, int lane) {
    const int nblk = N / 32, kb = item / nblk, nb = item % nblk, k0 = 64 * kb, n0 = 32 * nb;
#pragma unroll 8
    for (int i = 0; i < 32; ++i) { const int kk = 2 * i + (lane >> 5); scr[kk * 33 + (lane & 31)] = W[(size_t)(k0 + kk) * N + n0 + (lane & 31)]; }
    LDS_WAIT(); asm volatile("" ::: "memory");
    const int c = lane & 7;
#pragma unroll
    for (int j = 0; j < 4; ++j) { const int n = (lane >> 3) + 8 * j; const LAS float* s = scr + (8 * c) * 33 + n;
        v4u o; o.x = pk2(s[0 * 33], s[1 * 33]); o.y = pk2(s[2 * 33], s[3 * 33]); o.z = pk2(s[4 * 33], s[5 * 33]); o.w = pk2(s[6 * 33], s[7 * 33]);
        const int drow = PERMUTE ? win_dst_row(n0 + n) : (n0 + n);
        *(GAS v4u*)(WT + (size_t)drow * K + k0 + 8 * c) = o; }
    LDS_WAIT(); asm volatile("" ::: "memory");
}
typedef float f32x16 __attribute__((ext_vector_type(16)));
template <bool SILU>
__device__ __forceinline__ void gemv32_item(const float* in, int ldin, const float* W, int N, const float* bias, float* out, int ldout, int k0, int KS, int n0, int lane) {
    const int r = lane & 31, hh = lane >> 5;
    f32x16 acc;
#pragma unroll
    for (int i = 0; i < 16; ++i) acc[i] = 0.f;
#pragma unroll 8
    for (int kk = 0; kk < KS; kk += 2) {
        float a = in[(size_t)r * ldin + k0 + kk + hh]; if (SILU) a = a / (1.0f + __expf(-a));
        const float w = W[(size_t)(k0 + kk + hh) * N + n0 + r];
        acc = __builtin_amdgcn_mfma_f32_32x32x2f32(a, w, acc, 0, 0, 0);
    }
    const float bv = (bias && k0 == 0) ? bias[n0 + r] : 0.f;
#pragma unroll
    for (int i = 0; i < 16; ++i) { const int brow = (i & 3) + 8 * (i >> 2) + 4 * hh; atomicAdd(out + (size_t)brow * ldout + n0 + r, acc[i] + bv); }
}
__device__ __forceinline__ void sincos_d(double ang, float& sn, float& cs) {
    const double k = rint(ang * 0.63661977236758134308);
    const double t = (ang - k * 1.57079632679489655800) - k * 6.12323399573676603587e-17, t2 = t * t;
    double s = -1.0 / 6227020800.0; s = s * t2 + 1.0 / 39916800.0; s = s * t2 - 1.0 / 362880.0; s = s * t2 + 1.0 / 5040.0; s = s * t2 - 1.0 / 120.0; s = s * t2 + 1.0 / 6.0; s = t - t * t2 * s;
    double c = 1.0 / 479001600.0; c = c * t2 - 1.0 / 3628800.0; c = c * t2 + 1.0 / 40320.0; c = c * t2 - 1.0 / 720.0; c = c * t2 + 1.0 / 24.0; c = c * t2 - 0.5; c = 1.0 + t2 * c;
    const int q = (int)((long long)k & 3);
    const double ss = (q == 0) ? s : (q == 1) ? c : (q == 2) ? -s : -c;
    const double cc = (q == 0) ? c : (q == 1) ? -s : (q == 2) ? -c : s;
    sn = (float)ss; cs = (float)cc;
}

struct Ptrs {
    const float *x, *c, *ln1w, *ln2w, *wada, *bada, *win, *gnw, *wmo, *wro, *wout, *wff1, *wff2, *fnw;
    float* out; unsigned char* ws;
};

__device__ __forceinline__ void phase0(Frame& F, const Ptrs& P) {
    const int gw = F.vcu * NWAVES + F.wave, NGW = F.G * NWAVES;
    for (int gt = gw * 64 + F.lane; gt < 2 * 2048 * 32; gt += NGW * 64) {
        const int tb = gt >> 16, pos = (gt >> 5) & 2047, f = gt & 31;
        const double e = (tb == 0) ? (double)f * (1.0 / 32.0) : (double)f * (1.0 / 31.0);
        const double inv = exp2(-e * 13.28771237954945);
        float sn, cs; sincos_d((double)pos * inv, sn, cs);
        float* tab = (float*)(P.ws + WS_ROPE) + (size_t)tb * 2048 * 64 + pos * 64;
        tab[f] = cs; tab[32 + f] = sn;
    }
    for (int it = gw; it < 8 * 192; it += NGW) { const int ks = it / 192, cg = it % 192;
        gemv32_item<true>(P.c, D, P.wada, NADA, P.bada, (float*)(P.ws + WS_ADA), NADA, ks * 128, 128, cg * 32, F.lane); }
    LAS float* scr = (LAS float*)(F.lds + RING_OFF + F.wave * 16384);
    constexpr int I_IN = (D / 64) * (NIN / 32), I_MO = (512 / 64) * (D / 32), I_RO = (D / 64) * (D / 32), I_OUT = I_RO, I_1 = (D / 64) * (FF / 32), I_2 = (FF / 64) * (D / 32);
    constexpr int NITEMS = I_IN + I_MO + I_RO + I_OUT + I_1 + I_2;
    for (int it = gw; it < NITEMS; it += NGW) {
        int r = it;
        if (r < I_IN) { p0_transpose_item<true>(P.win, D, NIN, (bf16*)(P.ws + WS_WIN), scr, r, F.lane); continue; } r -= I_IN;
        if (r < I_MO) { p0_transpose_item<false>(P.wmo, 512, D, (bf16*)(P.ws + WS_WMO), scr, r, F.lane); continue; } r -= I_MO;
        if (r < I_RO) { p0_transpose_item<false>(P.wro, D, D, (bf16*)(P.ws + WS_WRO), scr, r, F.lane); continue; } r -= I_RO;
        if (r < I_OUT) { p0_transpose_item<false>(P.wout, D, D, (bf16*)(P.ws + WS_WOUT), scr, r, F.lane); continue; } r -= I_OUT;
        if (r < I_1) { p0_transpose_item<false>(P.wff1, D, FF, (bf16*)(P.ws + WS_W1), scr, r, F.lane); continue; } r -= I_1;
        p0_transpose_item<false>(P.wff2, FF, D, (bf16*)(P.ws + WS_W2), scr, r, F.lane);
    }
}
__device__ __forceinline__ void phase1(Frame& F, const Ptrs& P) {
    const int gw = F.vcu * NWAVES + F.wave, NGW = F.G * NWAVES;
    const float* ada = (const float*)(P.ws + WS_ADA);
    for (int it = gw; it < 8 * 128; it += NGW) { const int ks = it / 128, cg = it % 128;
        gemv32_item<false>(ada + 3 * D, NADA, P.wff1, FF, nullptr, (float*)(P.ws + WS_C1), FF, ks * 128, 128, cg * 32, F.lane); }
    bf16* H = (bf16*)(P.ws + WS_H);
    for (int r0 = gw * 32; r0 < M; r0 += NGW * 32) {
        const int b = r0 >> 11;
        f32x4 we[4], sh[4];
#pragma unroll
        for (int j = 0; j < 4; ++j) { const int c = 4 * F.lane + 256 * j; const f32x4 w = *(const f32x4*)(P.ln1w + c), s = *(const f32x4*)(ada + (size_t)b * NADA + D + c);
            we[j] = w * (s + 1.0f); sh[j] = *(const f32x4*)(ada + (size_t)b * NADA + c); }
        for (int rr = 0; rr < 32; rr += 2) {
            f32x4 v[2][4]; float s2[2] = {0.f, 0.f};
#pragma unroll
            for (int q = 0; q < 2; ++q) { const GAS f32x4* xr = (const GAS f32x4*)(P.x + (size_t)(r0 + rr + q) * D) + F.lane;
#pragma unroll
                for (int j = 0; j < 4; ++j) v[q][j] = xr[64 * j]; }
#pragma unroll
            for (int q = 0; q < 2; ++q) {
#pragma unroll
                for (int j = 0; j < 4; ++j) s2[q] += (v[q][j].x * v[q][j].x + v[q][j].y * v[q][j].y) + (v[q][j].z * v[q][j].z + v[q][j].w * v[q][j].w);
                const float rstd = 1.0f / sqrtf(wave_sum(s2[q]) * (1.0f / D) + EPSN);
                GAS unsigned long long* o8 = (GAS unsigned long long*)(H + (size_t)(r0 + rr + q) * D) + F.lane;
#pragma unroll
                for (int j = 0; j < 4; ++j) { const f32x4 y = v[q][j] * rstd * we[j] + sh[j];
                    o8[64 * j] = (unsigned long long)pk2(y.x, y.y) | ((unsigned long long)pk2(y.z, y.w) << 32); }
            }
        }
    }
}
__device__ __forceinline__ void phase8(Frame& F, const Ptrs& P) {
    const int gw = F.vcu * NWAVES + F.wave, NGW = F.G * NWAVES;
    const float* ss2 = (const float*)(P.ws + WS_SS2);
    f32x4 fw[4];
#pragma unroll
    for (int j = 0; j < 4; ++j) fw[j] = *(const f32x4*)(P.fnw + 4 * F.lane + 256 * j);
    for (int r0 = gw * 32; r0 < M; r0 += NGW * 32) {
        for (int rr = 0; rr < 32; rr += 2) {
            f32x4 v[2][4];
#pragma unroll
            for (int q = 0; q < 2; ++q) { const GAS f32x4* xr = (const GAS f32x4*)(P.out + (size_t)(r0 + rr + q) * D) + F.lane;
#pragma unroll
                for (int j = 0; j < 4; ++j) v[q][j] = xr[64 * j]; }
#pragma unroll
            for (int q = 0; q < 2; ++q) { const float rstd = 1.0f / sqrtf(ss2[r0 + rr + q] * (1.0f / D) + EPSN);
                GAS f32x4* xo = (GAS f32x4*)(P.out + (size_t)(r0 + rr + q) * D) + F.lane;
#pragma unroll
                for (int j = 0; j < 4; ++j) xo[64 * j] = v[q][j] * rstd * fw[j]; }
        }
    }
}

__device__ __forceinline__ void unpack8(const v4u w, float* f) {
    f[0] = __builtin_bit_cast(float, w.x << 16); f[1] = __builtin_bit_cast(float, w.x & 0xffff0000u); f[2] = __builtin_bit_cast(float, w.y << 16); f[3] = __builtin_bit_cast(float, w.y & 0xffff0000u);
    f[4] = __builtin_bit_cast(float, w.z << 16); f[5] = __builtin_bit_cast(float, w.z & 0xffff0000u); f[6] = __builtin_bit_cast(float, w.w << 16); f[7] = __builtin_bit_cast(float, w.w & 0xffff0000u);
}
__device__ __forceinline__ unsigned moba_select(const float (&g)[7], int qb) {
    unsigned sel = 0;
#pragma unroll
    for (int j = 0; j < 7; ++j) { int cnt = 0;
#pragma unroll
        for (int k = 0; k < 7; ++k) if (k != j) cnt += (k < qb) && ((g[k] > g[j]) || (g[k] == g[j] && k < j));
        if (j < qb && cnt < 3) sel |= 1u << j; }
    return sel;
}
__device__ void naive_moba(Frame& F, const Ptrs& P) {
    const bf16* MQ = (const bf16*)(P.ws + WS_MQ); const bf16* MK = (const bf16*)(P.ws + WS_MK); const bf16* MV = (const bf16*)(P.ws + WS_MV); bf16* O = (bf16*)(P.ws + WS_MQ);
    const float* ksum = (const float*)(P.ws + WS_KSUM);
    const int gt0 = (F.vcu * NWAVES + F.wave) * 64 + F.lane, NT = F.G * NWAVES * 64;
    for (int idx = gt0; idx < BATCH * 8 * SEQ; idx += NT) {
        const int s = idx & 2047, bh = idx >> 11, b = bh >> 3, h = bh & 7, qb = s >> 8; const size_t row = (size_t)b * SEQ + s;
        float q[64];
#pragma unroll
        for (int i = 0; i < 8; ++i) unpack8(*(const v4u*)(MQ + row * 512 + h * 64 + 8 * i), q + 8 * i);
        float g[7];
#pragma unroll
        for (int j = 0; j < 7; ++j) { float a = 0.f; if (j < qb) { const float* kp = ksum + (size_t)(b * 8 + j) * 512 + h * 64;
#pragma unroll
                for (int d = 0; d < 64; ++d) a += q[d] * kp[d]; } g[j] = a; }
        const unsigned sel = moba_select(g, qb);
        float mx = -INFINITY, l = 0.f; float o[64];
#pragma unroll
        for (int d = 0; d < 64; ++d) o[d] = 0.f;
        for (int it = 0; it <= qb; ++it) {
            const int j = (it == 0) ? qb : it - 1; if (it > 0 && !((sel >> j) & 1u)) continue;
            const int nk = (it == 0) ? (s & 255) + 1 : 256;
#pragma unroll 1
            for (int k = 0; k < nk; ++k) {
                const size_t kr = (size_t)b * SEQ + j * 256 + k; float a = 0.f;
#pragma unroll
                for (int c = 0; c < 8; ++c) { float kf[8]; unpack8(*(const v4u*)(MK + kr * 512 + h * 64 + 8 * c), kf);
#pragma unroll
                    for (int d = 0; d < 8; ++d) a += q[8 * c + d] * kf[d]; }
                if (a > mx) { const float f = __builtin_amdgcn_exp2f(mx - a); mx = a; l *= f;
#pragma unroll
                    for (int d = 0; d < 64; ++d) o[d] *= f; }
                const float p = __builtin_amdgcn_exp2f(a - mx); l += p;
#pragma unroll
                for (int c = 0; c < 8; ++c) { float vf[8]; unpack8(*(const v4u*)(MV + kr * 512 + h * 64 + 8 * c), vf);
#pragma unroll
                    for (int d = 0; d < 8; ++d) o[8 * c + d] += p * vf[d]; }
            }
        }
        const float rl = 1.0f / l;
#pragma unroll
        for (int i = 0; i < 8; ++i) { v4u w; w.x = pk2(o[8 * i] * rl, o[8 * i + 1] * rl); w.y = pk2(o[8 * i + 2] * rl, o[8 * i + 3] * rl); w.z = pk2(o[8 * i + 4] * rl, o[8 * i + 5] * rl); w.w = pk2(o[8 * i + 6] * rl, o[8 * i + 7] * rl);
            *(v4u*)(O + row * 512 + h * 64 + 8 * i) = w; }
    }
}
__device__ void naive_ret(Frame& F, const Ptrs& P) {
    const bf16* RQ = (const bf16*)(P.ws + WS_RQ); const bf16* RK = (const bf16*)(P.ws + WS_RK); const bf16* RV = (const bf16*)(P.ws + WS_RV); bf16* RG = (bf16*)(P.ws + WS_RG);
    LAS float* Qs = (LAS float*)(F.lds + RING_OFF); LAS float* Ks = Qs + 1024; LAS float* Vs = Ks + 1024; LAS float* Pt = Vs + 2048;
    const int t = F.tid, e = t & 127, grp = t >> 7, d0 = grp * 16;
    for (int u = F.vcu; u < BATCH * 8; u += F.G) {
        const int b = u >> 3, h = u & 7; const float gam = 1.0f - exp2f(-5.0f - (float)h);
        float S[16];
#pragma unroll
        for (int d = 0; d < 16; ++d) S[d] = 0.f;
        __syncthreads();
        for (int tb = 0; tb < SEQ / 16; ++tb) {
            const size_t rbase = (size_t)b * SEQ + tb * 16;
            { const int idx = 2 * t, tok = idx >> 6, d = idx & 63;
              const unsigned wq = *(const unsigned*)(RQ + (rbase + tok) * 512 + h * 64 + d), wk = *(const unsigned*)(RK + (rbase + tok) * 512 + h * 64 + d);
              Qs[idx] = __builtin_bit_cast(float, wq << 16); Qs[idx + 1] = __builtin_bit_cast(float, wq & 0xffff0000u);
              Ks[idx] = __builtin_bit_cast(float, wk << 16); Ks[idx + 1] = __builtin_bit_cast(float, wk & 0xffff0000u);
              const int iv = 4 * t, tv = iv >> 7, ev = iv & 127; const unsigned long long wv = *(const unsigned long long*)(RV + (rbase + tv) * 1024 + h * 128 + ev);
              const unsigned w0 = (unsigned)wv, w1 = (unsigned)(wv >> 32);
              Vs[iv] = __builtin_bit_cast(float, w0 << 16); Vs[iv + 1] = __builtin_bit_cast(float, w0 & 0xffff0000u); Vs[iv + 2] = __builtin_bit_cast(float, w1 << 16); Vs[iv + 3] = __builtin_bit_cast(float, w1 & 0xffff0000u); }
            __syncthreads();
            for (int tok = 0; tok < 16; ++tok) { const float v = Vs[tok * 128 + e]; float a = 0.f;
#pragma unroll
                for (int d = 0; d < 16; ++d) { S[d] = gam * S[d] + Ks[tok * 64 + d0 + d] * v; a += Qs[tok * 64 + d0 + d] * S[d]; }
                Pt[(tok * 4 + grp) * 128 + e] = a; }
            __syncthreads();
#pragma unroll
            for (int q = 0; q < 2; ++q) { const int tok = 2 * F.wave + q; const size_t row = rbase + tok;
                float o0 = 0.f, o1 = 0.f;
#pragma unroll
                for (int gI = 0; gI < 4; ++gI) { o0 += Pt[(tok * 4 + gI) * 128 + F.lane]; o1 += Pt[(tok * 4 + gI) * 128 + 64 + F.lane]; }
                const float mu = wave_sum(o0 + o1) * (1.0f / 128.0f); const float a0 = o0 - mu, a1 = o1 - mu;
                const float var = wave_sum(a0 * a0 + a1 * a1) * (1.0f / 128.0f); const float rs = 1.0f / sqrtf(var + EPSN);
                bf16* gp = RG + row * 1024 + h * 128;
                const float g0 = __builtin_bit_cast(float, (unsigned)gp[F.lane] << 16), g1 = __builtin_bit_cast(float, (unsigned)gp[64 + F.lane] << 16);
                gp[F.lane] = (bf16)f2bf(a0 * rs * P.gnw[h * 128 + F.lane] * g0); gp[64 + F.lane] = (bf16)f2bf(a1 * rs * P.gnw[h * 128 + 64 + F.lane] * g1); }
        }
    }
}
#include <hip/hip_bf16.h>
#include <cmath>
namespace attn_body {
using bf16=__hip_bfloat16;
using bf16x8=__attribute__((ext_vector_type(8)))short;
using s16x4=__attribute__((ext_vector_type(4)))short;
using f32x16=__attribute__((ext_vector_type(16)))float;
using u32x4=__attribute__((ext_vector_type(4)))unsigned;
constexpr int BATCH=32,NHEAD=8,SEQ=2048,D=64,DM=NHEAD*D;
constexpr int NW=8,QBLK=32,QB=QBLK*NW,KVBLK=64,NQB=SEQ/QB;
constexpr int ATTN_PITCH=DM, ATTN_UNIT_ROWS=QB;
__device__ __forceinline__ int crow(int r,int hi){return (r&3)+8*(r>>2)+4*hi;}
#define SBAR() __builtin_amdgcn_sched_barrier(0)
__device__ __forceinline__ void cmask(f32x16&p0,f32x16&p1,int jb,int qrel,int hi){
  const float NEG=-INFINITY; int kb=64*jb+4*hi;
  #pragma unroll
  for(int r=0;r<16;++r){int kv=kb+(r&3)+8*(r>>2); if(kv>qrel)p0[r]=NEG; if(kv+32>qrel)p1[r]=NEG;}
}

constexpr int NSLOT=3, SLOTB=8192;
constexpr int LDS_K=0, LDS_V=NSLOT*SLOTB, LDS_WS=2*NSLOT*SLOTB, LDS_OST=LDS_WS+NW*64*4, LDS_BYTES=LDS_OST+NW*4096;
constexpr float C2=0.125f*1.4426950408889634f;
__device__ __forceinline__ void glds16(const void*gsrc,unsigned lds_dst){unsigned keep;
  asm volatile("s_mov_b32 %0, m0\n\ts_mov_b32 m0, %2\n\ts_nop 0\n\tglobal_load_lds_dwordx4 %1, off\n\ts_mov_b32 m0, %0":"=&s"(keep):"v"(gsrc),"s"(lds_dst):"memory");}
__device__ __forceinline__ float max3f(float a,float b,float c){float r;asm("v_max3_f32 %0, %1, %2, %3":"=v"(r):"v"(a),"v"(b),"v"(c));return r;}
__device__ __forceinline__ float max2f(float a,float b){float r;asm("v_max_f32_e32 %0, %1, %2":"=v"(r):"v"(a),"v"(b));return r;}
__device__ __forceinline__ float fadd_s(float a,float b){float r;asm("v_add_f32_e32 %0, %1, %2":"=v"(r):"v"(a),"v"(b));return r;}
__device__ __forceinline__ float fsub_s(float a,float b){float r;asm("v_sub_f32_e32 %0, %1, %2":"=v"(r):"v"(a),"v"(b));return r;}
typedef float f32x2_t __attribute__((ext_vector_type(2))); typedef __bf16 bf16x2_t __attribute__((ext_vector_type(2)));
__device__ __forceinline__ unsigned cvtpk_s(float lo,float hi){f32x2_t v={lo,hi};bf16x2_t b=__builtin_convertvector(v,bf16x2_t);return __builtin_bit_cast(unsigned,b);}
#define WAIT_BAR(N) asm volatile("s_waitcnt vmcnt(" #N ") lgkmcnt(0)\n\ts_barrier":::"memory")

__device__ __forceinline__ void qkt(f32x16&p0,f32x16&p1,const char*Kslot,const bf16x8*qr,const f32x16&negm,int r32,int hi){
  const char*kb=Kslot+hi*1024+r32*16;
  #pragma unroll
  for(int d0=0;d0<4;++d0){
    const bf16x8 b0=*reinterpret_cast<const bf16x8*>(kb+d0*2048);
    const bf16x8 b1=*reinterpret_cast<const bf16x8*>(kb+d0*2048+512);
    if(d0==0){p0=__builtin_amdgcn_mfma_f32_32x32x16_bf16(b0,qr[0],negm,0,0,0);p1=__builtin_amdgcn_mfma_f32_32x32x16_bf16(b1,qr[0],negm,0,0,0);}
    else{p0=__builtin_amdgcn_mfma_f32_32x32x16_bf16(b0,qr[d0],p0,0,0,0);p1=__builtin_amdgcn_mfma_f32_32x32x16_bf16(b1,qr[d0],p1,0,0,0);}}
}
typedef __attribute__((address_space(3))) const char* lds_cptr;
typedef short v4i16_t __attribute__((ext_vector_type(4)));
__device__ __forceinline__ void kload8(bf16x8*kf,lds_cptr kp){
  kf[0]=*(const __attribute__((address_space(3))) bf16x8*)(kp);      kf[1]=*(const __attribute__((address_space(3))) bf16x8*)(kp+512);
  kf[2]=*(const __attribute__((address_space(3))) bf16x8*)(kp+2048); kf[3]=*(const __attribute__((address_space(3))) bf16x8*)(kp+2560);
  kf[4]=*(const __attribute__((address_space(3))) bf16x8*)(kp+4096); kf[5]=*(const __attribute__((address_space(3))) bf16x8*)(kp+4608);
  kf[6]=*(const __attribute__((address_space(3))) bf16x8*)(kp+6144); kf[7]=*(const __attribute__((address_space(3))) bf16x8*)(kp+6656);
}
__device__ __forceinline__ void kload2(bf16x8*kf,lds_cptr kp,int j){ kf[2*j]=*(const __attribute__((address_space(3))) bf16x8*)(kp+j*2048); kf[2*j+1]=*(const __attribute__((address_space(3))) bf16x8*)(kp+j*2048+512); }
__device__ __forceinline__ s16x4 vtr(lds_cptr p){ return __builtin_bit_cast(s16x4,__builtin_amdgcn_ds_read_tr16_b64_v4i16((__attribute__((address_space(3))) v4i16_t*)p)); }
__device__ __forceinline__ float rowmax(const f32x16&p0,const f32x16&p1){
  float a=max3f(p0[0],p0[1],p1[0]),b=max3f(p0[2],p0[3],p1[1]);a=max3f(a,p1[2],p1[3]);
  #pragma unroll
  for(int r=4;r<16;r+=4){a=max3f(a,p0[r],p0[r+1]);b=max3f(b,p0[r+2],p0[r+3]);a=max3f(a,p1[r],p1[r+1]);b=max3f(b,p1[r+2],p1[r+3]);}
  const float m=max2f(a,b);
  auto rr=__builtin_amdgcn_permlane32_swap(__float_as_uint(m),__float_as_uint(m),false,false);
  return max2f(__uint_as_float(rr[0]),__uint_as_float(rr[1]));
}
__device__ __forceinline__ void pv(f32x16*o,int vb,bf16x8 pa0,bf16x8 pa1,bf16x8 pa2,bf16x8 pa3){
  #pragma unroll
  for(int d0=0;d0<2;++d0){s16x4 lo[4],hi[4];
    #pragma unroll
    for(int ks=0;ks<4;++ks){
      asm volatile("ds_read_b64_tr_b16 %0,%1 offset:%c2":"=&v"(lo[ks]):"v"(vb),"i"(d0*4096+ks*1024):"memory");
      asm volatile("ds_read_b64_tr_b16 %0,%1 offset:%c2":"=&v"(hi[ks]):"v"(vb),"i"(d0*4096+ks*1024+512):"memory");}
    asm volatile("s_waitcnt lgkmcnt(0)":::"memory");SBAR();
    #define PK(k) (bf16x8){lo[k][0],lo[k][1],lo[k][2],lo[k][3],hi[k][0],hi[k][1],hi[k][2],hi[k][3]}
    o[d0]=__builtin_amdgcn_mfma_f32_32x32x16_bf16(pa0,PK(0),o[d0],0,0,0);
    o[d0]=__builtin_amdgcn_mfma_f32_32x32x16_bf16(pa1,PK(1),o[d0],0,0,0);
    o[d0]=__builtin_amdgcn_mfma_f32_32x32x16_bf16(pa2,PK(2),o[d0],0,0,0);
    o[d0]=__builtin_amdgcn_mfma_f32_32x32x16_bf16(pa3,PK(3),o[d0],0,0,0);
    #undef PK
  }
}

#ifndef ATTN_STORE16
#define ATTN_STORE16(p,v) (*(u32x4*)(p)=(v))
#endif
template<int THRL> __device__ __forceinline__ void attn_unit(int b,int h,int qb,const bf16*Q,const bf16*__restrict__ K,const bf16*__restrict__ V,bf16*O,char*shm,const float*ksum){
  int tid_=threadIdx.x; asm volatile("":"+v"(tid_));
  const int tid=tid_,lane=tid&63,r32=lane&31,hi=lane>>5; const int wid=__builtin_amdgcn_readfirstlane(tid>>6);
  const long rowbase=(long)b*SEQ; const int q0=qb*QB;
  const bf16*Qw=Q+(rowbase+q0+wid*QBLK)*DM+h*D;
  const bf16*Kh=K+rowbase*DM+h*D,*Vh=V+rowbase*DM+h*D;
  const unsigned lds0=(unsigned)(uintptr_t)shm;
  float*wsf=(float*)(shm+LDS_WS)+wid*64;
  const bf16*ksrc=Kh+(long)lane*DM+wid*8;
  const bf16*vsrc=Vh+(long)(16*(wid&3)+(lane>>2))*DM+(wid>>2)*32+(lane&3)*8;
  const unsigned kdst=lds0+LDS_K+wid*1024, vdst=lds0+LDS_V+wid*1024;
  #define KT(t) (((t)<4)?(4*qb+(t)):((t)-4))
  #define DMA_K(t,slot) glds16(ksrc+(long)KT(t)*KVBLK*DM,(unsigned)__builtin_amdgcn_readfirstlane(kdst+(slot)))
  #define DMA_V(t,slot) glds16(vsrc+(long)KT(t)*KVBLK*DM,(unsigned)__builtin_amdgcn_readfirstlane(vdst+(slot)))
  const int vb0=(int)(lds0+LDS_V)+((lane>>4)&1)*32+(lane&3)*8+(4*hi+((lane&15)>>2))*64;
  const char*Kbase=shm+LDS_K; bf16x8 kf[8];
  const lds_cptr shm3=(lds_cptr)shm; const lds_cptr kp0=shm3+LDS_K+hi*1024+r32*16; const lds_cptr vp0=shm3+LDS_V+((lane>>4)&1)*32+(lane&3)*8+(4*hi+((lane&15)>>2))*64;
  const int NT=(q0+QB)/KVBLK;
  DMA_K(0,0);DMA_V(0,0);DMA_K(1,SLOTB);
  bf16x8 qr[4];
  #pragma unroll
  for(int d0=0;d0<4;++d0)qr[d0]=*reinterpret_cast<const bf16x8*>(&Qw[(long)r32*DM+d0*16+hi*8]);

  unsigned selbits=0u;
  if(qb>0){ float gsc[7]; typedef float f32x4v __attribute__((ext_vector_type(4)));
    #pragma unroll
    for(int k=0;k<7;++k)gsc[k]=0.f;
    #pragma unroll 1
    for(int j=0;j<qb;++j){ float a=0.f; const float*kp=ksum+((long)(b*8+j))*512+h*64+hi*8;
      #pragma unroll
      for(int d0=0;d0<4;++d0){ const f32x4v k0=*(const f32x4v*)(kp+d0*16), k1=*(const f32x4v*)(kp+d0*16+4);
        #pragma unroll
        for(int e=0;e<4;++e){ a+=__builtin_bit_cast(float,((unsigned)(unsigned short)qr[d0][e])<<16)*k0[e]; a+=__builtin_bit_cast(float,((unsigned)(unsigned short)qr[d0][4+e])<<16)*k1[e]; } }
      a+=__shfl_xor(a,32);
      #pragma unroll
      for(int k=0;k<7;++k)gsc[k]=(k==j)?a:gsc[k]; }
    selbits=::moba_select(gsc,qb); }
  float mhat=0.f,l_reg=0.f;f32x16 o[2];f32x16 negm;{float z_;asm volatile("v_mov_b32 %0, 0":"=v"(z_));
    _Pragma("unroll") for(int r=0;r<16;++r){o[0][r]=z_;o[1][r]=z_;negm[r]=z_;}}asm volatile("":"+v"(negm));
  const int qrel=wid*QBLK+r32;
  #define CMASK(P0,P1,t) do{ if((t)<4){cmask(P0,P1,(t),qrel,hi);} else { const float ad_=((selbits>>(((t)-4)>>2))&1u)?0.f:-INFINITY; _Pragma("unroll") for(int r_=0;r_<16;++r_){P0[r_]+=ad_;P1[r_]+=ad_;} } }while(0)
  bool resc=false;
  #define START(P0,P1) do{ const float rm=rowmax(P0,P1); resc=false; \
    { const float dl=rm; mhat=fadd_s(mhat,dl); \
      _Pragma("unroll") for(int r=0;r<16;++r){P0[r]=fsub_s(P0[r],dl);P1[r]=fsub_s(P1[r],dl);} \
      _Pragma("unroll") for(int r=0;r<16;++r)negm[r]=-mhat; asm volatile("":"+v"(negm)); } \
    _Pragma("unroll") for(int r=0;r<16;++r)P0[r]=__builtin_amdgcn_exp2f(P0[r]); }while(0)
  #define RESC() do{ if(resc){ asm volatile("s_waitcnt lgkmcnt(0)":::"memory"); \
      _Pragma("unroll") for(int d_=0;d_<2;++d_) _Pragma("unroll") for(int r=0;r<16;++r)o[d_][r]*=wsf[crow(r,hi)]; } }while(0)
  f32x16 pA0,pA1,pB0,pB1;
  int sl_prev=0,sl_cur=0,sl_next=SLOTB;
  #define ROT() do{sl_prev=sl_cur;sl_cur=sl_next;sl_next=(sl_next==(NSLOT-1)*SLOTB)?0:sl_next+SLOTB;}while(0)
  DMA_K(2,2*SLOTB);
  WAIT_BAR(3);
  qkt(pA0,pA1,Kbase,qr,negm,r32,hi);asm volatile("s_nop 15\n\ts_nop 7":"+v"(pA0),"+v"(pA1));cmask(pA0,pA1,0,qrel,hi);
  START(pA0,pA1);
  _Pragma("unroll") for(int r=0;r<16;++r)pA1[r]=__builtin_amdgcn_exp2f(pA1[r]);
  WAIT_BAR(0);
  DMA_K(3,0);DMA_V(1,SLOTB);
  ROT();
  kload8(kf,kp0+sl_cur);
  WAIT_BAR(2);
  s16x4 vlo[8],vhi[8]; u32x4 pw0,pw1,pw2,pw3;
  #define PKW(P,B) cvtpk_s(P[B],P[B+1])
  #define PAF(k) __builtin_bit_cast(bf16x8,pw##k)
  #define VFR(i) (bf16x8){vlo[i][0],vlo[i][1],vlo[i][2],vlo[i][3],vhi[i][0],vhi[i][1],vhi[i][2],vhi[i][3]}
  #define PIN(x) asm volatile("":"+v"(x))
  #define MX3(a,b,c) __builtin_fmaxf(__builtin_fmaxf((a),(b)),(c))
  #define GAPA(MF,A0,A1,A2,A3,W0,W1,PW) do{ MF; sacc+=A0; sacc+=A1; sacc+=A2; sacc+=A3; PIN(sacc); W0; W1; PIN(PW); SBAR(); }while(0)
  #define EX(v) __builtin_amdgcn_exp2f(v)
  #define GAPB(MF,X,B) do{ MF; X[B]=EX(X[B]); X[B+1]=EX(X[B+1]); X[B+2]=EX(X[B+2]); X[B+3]=EX(X[B+3]); PIN(X); SBAR(); }while(0)
  #define VRD(i) do{ vlo[i]=vtr(vp_+(((i)>>2)*4096+((i)&3)*1024)); vhi[i]=vtr(vp_+(((i)>>2)*4096+((i)&3)*1024+512)); }while(0)
  #define KRD(G,j) do{ if(G){ kload2(kf,kp0+sl_next,j); SBAR(); } }while(0)
  #define STEP(C0,C1,P0,P1,t,GK,GV,GL) do{ SBAR(); \
    const lds_cptr vp_=vp0+sl_prev; \
    VRD(0); SBAR(); float sacc=(P0[0]+P0[1]); \
    GAPA(C0=__builtin_amdgcn_mfma_f32_32x32x16_bf16(kf[0],qr[0],negm,0,0,0), P0[2],P0[3],P0[4],P0[5],     pw0[0]=PKW(P0,0), pw0[1]=PKW(P0,2), pw0); \
    VRD(4); SBAR(); GAPA(C1=__builtin_amdgcn_mfma_f32_32x32x16_bf16(kf[1],qr[0],negm,0,0,0), P0[6],P0[7],P0[8],P0[9],     pw0[2]=PKW(P0,4), pw0[3]=PKW(P0,6), pw0); \
    VRD(1); SBAR(); GAPA(C0=__builtin_amdgcn_mfma_f32_32x32x16_bf16(kf[2],qr[1],C0,0,0,0),   P0[10],P0[11],P0[12],P0[13], pw1[0]=PKW(P0,8), pw1[1]=PKW(P0,10), pw1); \
    VRD(5); SBAR(); GAPA(C1=__builtin_amdgcn_mfma_f32_32x32x16_bf16(kf[3],qr[1],C1,0,0,0),   P0[14],P0[15],P1[0],P1[1],   pw1[2]=PKW(P0,12),pw1[3]=PKW(P0,14), pw1); \
    VRD(2); SBAR(); GAPA(C0=__builtin_amdgcn_mfma_f32_32x32x16_bf16(kf[4],qr[2],C0,0,0,0),   P1[2],P1[3],P1[4],P1[5],     pw2[0]=PKW(P1,0), pw2[1]=PKW(P1,2), pw2); \
    VRD(6); SBAR(); GAPA(C1=__builtin_amdgcn_mfma_f32_32x32x16_bf16(kf[5],qr[2],C1,0,0,0),   P1[6],P1[7],P1[8],P1[9],     pw2[2]=PKW(P1,4), pw2[3]=PKW(P1,6), pw2); \
    VRD(3); SBAR(); GAPA(C0=__builtin_amdgcn_mfma_f32_32x32x16_bf16(kf[6],qr[3],C0,0,0,0),   P1[10],P1[11],P1[12],P1[13], pw3[0]=PKW(P1,8), pw3[1]=PKW(P1,10), pw3); \
    VRD(7); SBAR(); GAPA(C1=__builtin_amdgcn_mfma_f32_32x32x16_bf16(kf[7],qr[3],C1,0,0,0),   P1[14],P1[15],0.f,0.f,       pw3[2]=PKW(P1,12),pw3[3]=PKW(P1,14), pw3); \
    l_reg+=sacc; \
    if(GK){DMA_K((t)+3,sl_cur);} if(GV){DMA_V((t)+1,sl_next);} \
    CMASK(C0,C1,t); \
    { float a=MX3(C0[0],C0[1],C1[0]),b=MX3(C0[2],C0[3],C1[1]); a=MX3(a,C1[2],C1[3]); \
      _Pragma("unroll") for(int r=4;r<16;r+=4){a=MX3(a,C0[r],C0[r+1]);b=MX3(b,C0[r+2],C0[r+3]);a=MX3(a,C1[r],C1[r+1]);b=MX3(b,C1[r+2],C1[r+3]);} \
      float rm=__builtin_fmaxf(a,b); { auto rr=__builtin_amdgcn_permlane32_swap(__float_as_uint(rm),__float_as_uint(rm),false,false); rm=__builtin_fmaxf(__uint_as_float(rr[0]),__uint_as_float(rr[1])); } \
      resc=false; \
      if(__builtin_expect(__any(rm>(float)THRL),0)){ const float dl=__builtin_fmaxf(rm,0.f); mhat+=dl; \
        _Pragma("unroll") for(int r=0;r<16;++r){C0[r]-=dl;C1[r]-=dl;} \
        _Pragma("unroll") for(int r=0;r<16;++r)negm[r]=-mhat; asm volatile("":"+v"(negm)); \
        const float f=__builtin_amdgcn_exp2f(-dl); l_reg*=f; if(hi==0)wsf[r32]=f; resc=true; } } \
    SBAR(); \
    GAPB(o[0]=__builtin_amdgcn_mfma_f32_32x32x16_bf16(PAF(0),VFR(0),o[0],0,0,0), C0,0); \
    GAPB(o[1]=__builtin_amdgcn_mfma_f32_32x32x16_bf16(PAF(0),VFR(4),o[1],0,0,0), C0,4); \
    KRD(GL,0); GAPB(o[0]=__builtin_amdgcn_mfma_f32_32x32x16_bf16(PAF(1),VFR(1),o[0],0,0,0), C0,8); \
    KRD(GL,1); GAPB(o[1]=__builtin_amdgcn_mfma_f32_32x32x16_bf16(PAF(1),VFR(5),o[1],0,0,0), C0,12); \
    KRD(GL,2); GAPB(o[0]=__builtin_amdgcn_mfma_f32_32x32x16_bf16(PAF(2),VFR(2),o[0],0,0,0), C1,0); \
    KRD(GL,3); GAPB(o[1]=__builtin_amdgcn_mfma_f32_32x32x16_bf16(PAF(2),VFR(6),o[1],0,0,0), C1,4); \
    GAPB(o[0]=__builtin_amdgcn_mfma_f32_32x32x16_bf16(PAF(3),VFR(3),o[0],0,0,0), C1,8); \
    GAPB(o[1]=__builtin_amdgcn_mfma_f32_32x32x16_bf16(PAF(3),VFR(7),o[1],0,0,0), C1,12); \
    }while(0)
  int t=1;
  #undef CMASK
  #define CMASK(P0,P1,t) do{ if((t)<4){cmask(P0,P1,(t),qrel,hi);} else { const float ad_=((selbits>>(((t)-4)>>2))&1u)?0.f:-INFINITY; _Pragma("unroll") for(int r_=0;r_<16;++r_){P0[r_]+=ad_;P1[r_]+=ad_;} } }while(0)
  for(;t+5<NT;t+=2){
    STEP(pB0,pB1,pA0,pA1,t,true,true,true);     WAIT_BAR(2); RESC(); ROT();
    STEP(pA0,pA1,pB0,pB1,t+1,true,true,true);   WAIT_BAR(2); RESC(); ROT();
  }
  #undef CMASK
  #define CMASK(P0,P1,t) do{ if((t)<4){cmask(P0,P1,(t),qrel,hi);} else { const float ad_=((selbits>>(((t)-4)>>2))&1u)?0.f:-INFINITY; _Pragma("unroll") for(int r_=0;r_<16;++r_){P0[r_]+=ad_;P1[r_]+=ad_;} } }while(0)
  #define ENDW(tt) do{ if((tt)+3<NT){WAIT_BAR(2);} else if((tt)+2<NT){WAIT_BAR(1);} else {WAIT_BAR(0);} }while(0)
  for(;t+1<NT;t+=2){
    STEP(pB0,pB1,pA0,pA1,t,(t+3<NT),(t+1<NT),(t+1<NT));       ENDW(t);   RESC(); ROT();
    STEP(pA0,pA1,pB0,pB1,t+1,(t+4<NT),(t+2<NT),(t+2<NT));     ENDW(t+1); RESC(); ROT();
  }
  STEP(pB0,pB1,pA0,pA1,NT-1,false,false,false); RESC();
  { float sacc=pB0[0]+pB0[1]; _Pragma("unroll") for(int r=2;r<16;++r)sacc+=pB0[r]; _Pragma("unroll") for(int r=0;r<16;++r)sacc+=pB1[r]; l_reg+=sacc;
    pw0=(u32x4){PKW(pB0,0),PKW(pB0,2),PKW(pB0,4),PKW(pB0,6)};pw1=(u32x4){PKW(pB0,8),PKW(pB0,10),PKW(pB0,12),PKW(pB0,14)};pw2=(u32x4){PKW(pB1,0),PKW(pB1,2),PKW(pB1,4),PKW(pB1,6)};pw3=(u32x4){PKW(pB1,8),PKW(pB1,10),PKW(pB1,12),PKW(pB1,14)};
    SBAR(); pv(o,vb0+sl_cur,PAF(0),PAF(1),PAF(2),PAF(3)); }
  #undef PKW
  #undef PAF
  #undef VFR
  #undef PIN
  #undef MX3
  #undef GAPA
  #undef GAPB
  #undef EX
  #undef VRD
  #undef KRD
  #undef STEP
  #undef ENDW
  {auto rr=__builtin_amdgcn_permlane32_swap(__float_as_uint(l_reg),__float_as_uint(l_reg),false,false);l_reg=__uint_as_float(rr[0])+__uint_as_float(rr[1]);}
  if(hi==0)wsf[32+r32]=l_reg;asm volatile("s_waitcnt lgkmcnt(0)":::"memory");
  float rli[16];
  #pragma unroll
  for(int r=0;r<16;++r)rli[r]=__builtin_amdgcn_rcpf(wsf[32+crow(r,hi)]);
  bf16*Ow=O+(rowbase+q0+wid*QBLK)*DM+h*D;
  { bf16*stg=(bf16*)(shm+LDS_OST)+wid*2048;
    #pragma unroll
    for(int r=0;r<16;++r){const int orow=crow(r,hi);
      #pragma unroll
      for(int d0=0;d0<2;++d0)stg[orow*64+d0*32+r32]=__float2bfloat16(o[d0][r]*rli[r]);}
    asm volatile("s_waitcnt lgkmcnt(0)":::"memory");
    #pragma unroll
    for(int i=0;i<4;++i){const int row=i*8+(lane>>3),ch=lane&7; const u32x4 v=*(const u32x4*)(stg+row*64+ch*8); ATTN_STORE16(Ow+(long)row*DM+ch*8,v);} }
  asm volatile("s_waitcnt lgkmcnt(0)\n\ts_barrier":::"memory");
  #undef DMA_K
  #undef KT
  #undef DMA_V
  #undef CMASK
  #undef START
  #undef RESC
  #undef ROT
}
constexpr int ATTN_LDS_BYTES=LDS_BYTES;
struct AttnTensors { const bf16* Q; const bf16* K; const bf16* V; bf16* O; const float* ksum; };
struct AttnUnit { int bh; int qb; };
struct StaticOrder {
  int vcu,G;
  __device__ __forceinline__ explicit StaticOrder(int grid,int block):vcu((grid%8==0)?(block%8)*(grid/8)+block/8:block),G(grid){}
  __device__ __forceinline__ bool next(int i,AttnUnit&u)const{ const int bh=vcu+(i>>3)*G; if(bh>=BATCH*NHEAD)return false; u.bh=bh; u.qb=i&7; return true; }
  __device__ __forceinline__ void a_ready(const AttnUnit&)const{}
  __device__ __forceinline__ void done(const AttnUnit&)const{}
};
template<class Sched,int THRL=8> __device__ __forceinline__ void attn_phase(char*lds,const AttnTensors&T,const Sched&S){
  AttnUnit u;
  for(int i=0;S.next(i,u);++i){ S.a_ready(u); attn_unit<THRL>(u.bh/NHEAD,u.bh%NHEAD,u.qb,T.Q,T.K,T.V,T.O,lds,T.ksum); S.done(u); }
}
#undef SBAR
#undef WAIT_BAR
}

#ifndef MK_N_LAUNCHES
#define MK_N_LAUNCHES 1
#endif
#ifndef FAST_ATTN
#define FAST_ATTN 1
#endif
#ifndef FAST_RET
#define FAST_RET 0
#endif
constexpr int N_PHASES = 9;
struct Args { const float* in[14]; float* out; unsigned char* ws; int ph_lo, ph_hi; };
__global__ void __launch_bounds__(NWAVES * 64, 2) fwd(Args args) {
    extern __shared__ __attribute__((aligned(16))) unsigned char lds[];
    Frame F;
    F.lds = (LAS unsigned char*)lds;
    F.MISC = (volatile LAS unsigned*)(F.lds + MISC_OFF);
    F.tid = threadIdx.x; F.lane = F.tid & 63; F.wave = __builtin_amdgcn_readfirstlane(F.tid >> 6);
    F.G = gridDim.x; { const int bx = blockIdx.x; F.vcu = (F.G % 8 == 0) ? (bx % 8) * (F.G / 8) + bx / 8 : bx; }
    Ptrs P;
    P.x = args.in[0]; P.c = args.in[1]; P.ln1w = args.in[2]; P.ln2w = args.in[3]; P.wada = args.in[4]; P.bada = args.in[5]; P.win = args.in[6]; P.gnw = args.in[7];
    P.wmo = args.in[8]; P.wro = args.in[9]; P.wout = args.in[10]; P.wff1 = args.in[11]; P.wff2 = args.in[12]; P.fnw = args.in[13]; P.out = args.out; P.ws = args.ws;
    unsigned char* ws = args.ws;
    for (int u = F.tid; u < (LDS_BYTES - LDSCTL_OFF) / 4; u += NWAVES * 64) ((LAS unsigned*)(F.lds + LDSCTL_OFF))[u] = 0u;
    __syncthreads();
    const int lo = args.ph_lo, hi = args.ph_hi;
    XcdBarrier bar; bar.bar = (unsigned*)(ws + WS_CTL) + CW_BAR; bar.x = 0; bar.st = nullptr;
    if (hi - lo > 1) bar = xcd_barrier_post((unsigned*)(ws + WS_CTL) + CW_BAR, F.MISC + 8);
#ifndef PH_MASK
#define PH_MASK 0x1ff
#endif
#define IN(k) (((PH_MASK >> (k)) & 1) && lo <= (k) && (k) < hi)
#define SEAM(k) do { if (IN(k) && IN((k) + 1)) xcd_barrier(bar); } while (0)
    typedef pg8::bf16_t pb;
    const float* ada = (const float*)(ws + WS_ADA);

    if (IN(0)) { phase0(F, P); SEAM(0); }
    if (IN(1)) { phase1(F, P); SEAM(1); }
    if (IN(2)) {
        pg8::Gemm g{(const pb*)(ws + WS_H), (const pb*)(ws + WS_WIN), M, NIN, D}; pg8::StaticOrder S; S.init(M, NIN, F.G, (int)blockIdx.x);
        pg8::EpiIn E{(pb*)(ws + WS_MQ), (pb*)(ws + WS_MK), (pb*)(ws + WS_MV), (pb*)(ws + WS_RQ), (pb*)(ws + WS_RK), (pb*)(ws + WS_RV), (pb*)(ws + WS_RG), (pb*)(ws + WS_SGA), (pb*)(ws + WS_SGR),
                     (const float*)(ws + WS_ROPE), (const float*)(ws + WS_ROPE) + 2048 * 64, (float*)(ws + WS_KSUM), QSCALE};
        pg8::gemm_phase<pg8::EpiIn, pg8::StaticOrder, true, true>(F.lds + RING_OFF, g, S, E);
        SEAM(2);
    }
    if (IN(3)) {
#if FAST_ATTN
        { const attn_body::AttnTensors AT{(const attn_body::bf16*)(ws + WS_MQ), (const attn_body::bf16*)(ws + WS_MK), (const attn_body::bf16*)(ws + WS_MV), (attn_body::bf16*)(ws + WS_MQ), (const float*)(ws + WS_KSUM)};
          const attn_body::StaticOrder S((int)F.G, (int)blockIdx.x);
          attn_body::attn_phase<attn_body::StaticOrder>((char*)lds + RING_OFF, AT, S); }
#else
        naive_moba(F, P);
#endif
        naive_ret(F, P);
        SEAM(3);
    }
    if (IN(4)) {
        { pg8::Gemm g{(const pb*)(ws + WS_MQ), (const pb*)(ws + WS_WMO), M, D, 512}; pg8::StaticOrder S; S.init(M, D, F.G, (int)blockIdx.x);
          pg8::EpiMerge<false> E{(const pb*)(ws + WS_SGA), (pb*)(ws + WS_H)};
          pg8::gemm_phase<pg8::EpiMerge<false>, pg8::StaticOrder, true, true>(F.lds + RING_OFF, g, S, E); }
        { pg8::Gemm g{(const pb*)(ws + WS_RG), (const pb*)(ws + WS_WRO), M, D, D}; pg8::StaticOrder S; S.init(M, D, F.G, (int)blockIdx.x);
          pg8::EpiMerge<true> E{(const pb*)(ws + WS_SGR), (pb*)(ws + WS_H)};
          pg8::gemm_phase<pg8::EpiMerge<true>, pg8::StaticOrder, true, true>(F.lds + RING_OFF, g, S, E); }
        SEAM(4);
    }
    if (IN(5)) {
        pg8::Gemm g{(const pb*)(ws + WS_H), (const pb*)(ws + WS_WOUT), M, D, D}; pg8::StaticOrder S; S.init(M, D, F.G, (int)blockIdx.x);
        pg8::EpiRes E{P.x, P.out, ada + 2 * D, P.ln2w, ada + 4 * D, (pb*)(ws + WS_A2), (float*)(ws + WS_SS1)};
        pg8::gemm_phase<pg8::EpiRes, pg8::StaticOrder, true, true>(F.lds + RING_OFF, g, S, E);
        SEAM(5);
    }
    if (IN(6)) {
        pg8::Gemm g{(const pb*)(ws + WS_A2), (const pb*)(ws + WS_W1), M, FF, D}; pg8::StaticOrder S; S.init(M, FF, F.G, (int)blockIdx.x);
        pg8::EpiFF1 E{(pb*)(ws + WS_ACT), (const float*)(ws + WS_C1), (const float*)(ws + WS_SS1), EPSN};
        pg8::gemm_phase<pg8::EpiFF1, pg8::StaticOrder, true, true>(F.lds + RING_OFF, g, S, E);
        SEAM(6);
    }
    if (IN(7)) {
        pg8::Gemm g{(const pb*)(ws + WS_ACT), (const pb*)(ws + WS_W2), M, D, FF}; pg8::StaticOrder S; S.init(M, D, F.G, (int)blockIdx.x);
        pg8::EpiRes E{P.out, P.out, ada + 5 * D, nullptr, nullptr, nullptr, (float*)(ws + WS_SS2)};
        pg8::gemm_phase<pg8::EpiRes, pg8::StaticOrder, true, true>(F.lds + RING_OFF, g, S, E);
        SEAM(7);
    }
    if (IN(8)) { phase8(F, P); }
#undef IN
#undef SEAM
}

extern "C" void kernel_launch(void* const* d_in, const int* in_sizes, int n_in, void* d_out, int out_size, void* d_ws, size_t ws_size, hipStream_t stream) {
    static int grid = 0;
    if (grid == 0) {
        if (n_in != 14 || in_sizes[0] != M * D || out_size != M * D || ws_size < WS_END) { fprintf(stderr, "kernel_launch: shape/workspace mismatch: n_in %d in0 %d out %d ws %zu (need %zu)\n", n_in, n_in > 0 ? in_sizes[0] : -1, out_size, ws_size, (size_t)WS_END); grid = -1; return; }
        int dev = 0, cus = 0, per_cu = 0;
        if (hipGetDevice(&dev) != hipSuccess || hipDeviceGetAttribute(&cus, hipDeviceAttributeMultiprocessorCount, dev) != hipSuccess) { grid = -1; return; }
        if (hipFuncSetAttribute((const void*)fwd, hipFuncAttributeMaxDynamicSharedMemorySize, LDS_BYTES) != hipSuccess) { fprintf(stderr, "kernel_launch: hipFuncSetAttribute failed\n"); grid = -1; return; }
        if (hipOccupancyMaxActiveBlocksPerMultiprocessor(&per_cu, (const void*)fwd, NWAVES * 64, LDS_BYTES) != hipSuccess || per_cu < 1) { fprintf(stderr, "kernel_launch: occupancy query says %d blocks per CU\n", per_cu); }
        (void)hipGetLastError();
        grid = cus;
    }
    if (grid < 0) return;
    if (hipMemsetAsync((char*)d_ws + WS_CTL, 0, ZERO_BYTES, stream) != hipSuccess) { fprintf(stderr, "kernel_launch: memset failed\n"); return; }
    Args a{};
    for (int i = 0; i < 14; ++i) a.in[i] = (const float*)d_in[i];
    a.out = (float*)d_out; a.ws = (unsigned char*)d_ws;
    if (MK_N_LAUNCHES == 1) { a.ph_lo = 0; a.ph_hi = N_PHASES; hipLaunchKernelGGL(fwd, dim3(grid), dim3(NWAVES * 64), LDS_BYTES, stream, a); }
    else for (int li = 0; li < N_PHASES; ++li) { a.ph_lo = li; a.ph_hi = li + 1; hipLaunchKernelGGL(fwd, dim3(grid), dim3(NWAVES * 64), LDS_BYTES, stream, a); }
    const hipError_t le = hipPeekAtLastError();
    if (le != hipSuccess) fprintf(stderr, "kernel_launch: launch failed: %s\n", hipGetErrorName(le));
}
```

```cpp
#include <hip/hip_runtime.h>
#include <cstdio>
#include <cstdint>
#include <cmath>
namespace pg8 {
#define PG8_LAS __attribute__((address_space(3)))
typedef unsigned short bf16_t;
typedef short bf16x8 __attribute__((ext_vector_type(8)));
typedef float f32x4 __attribute__((ext_vector_type(4)));
typedef unsigned u32x4 __attribute__((ext_vector_type(4)));
constexpr int BM = 256, BK = 64, HALF = 128, HTB = HALF * BK * 2  , STAGE_BYTES = 8 * HTB, NXCD = 8, WGM = 8;

__host__ __device__ __forceinline__ int lds_byte(int r, int c) { const int st = (r >> 4) * 2 + (c >> 5), rr = r & 15, cc = c & 31, ob = rr * 64 + cc * 2; return st * 1024 + (ob ^ (((ob >> 9) & 1) << 5)); }
__host__ __device__ __forceinline__ void stage_rc(int b, int& R, int& C) { const int st = b / 1024, sb = b % 1024, swz = sb ^ (((sb >> 9) & 1) << 5); R = (st >> 1) * 16 + swz / 64; C = (st & 1) * 32 + (swz % 64) / 2; }
__host__ __device__ __forceinline__ int perm32(int rho) { const int n = rho >> 4, i = rho & 15; return 8 * (i >> 2) + 4 * n + (i & 3); }

struct Unit { int pm, pn; };
struct Gemm { const bf16_t* A; const bf16_t* Bt; int M, N, K; };

struct StaticOrder {
    int nM, nN, nwg, G, c;
    __host__ __device__ void init(int M, int N, int G_, int c_) { nM = M / BM; nN = N / BM; nwg = nM * nN; G = G_; c = c_; }
    __host__ __device__ bool next(int i, Unit& u) const {
        const long L = (long)i * G + c; if (L >= nwg) return false;
        int wgid = (int)L; { const int q = nwg / NXCD, r = nwg % NXCD, xcd = wgid % NXCD, off = wgid / NXCD; wgid = (xcd < r ? xcd * (q + 1) : r * (q + 1) + (xcd - r) * q) + off; }
        const int nig = WGM * nN, gid = wgid / nig, fm = gid * WGM, gsz = (nM - fm) < WGM ? (nM - fm) : WGM;
        u.pm = fm + ((wgid % nig) % gsz); u.pn = (wgid % nig) / gsz; return true;
    }
    __device__ __forceinline__ void a_ready(const Unit&) const {}
    __device__ __forceinline__ void done(const Unit&) const {}
};

__device__ __forceinline__ unsigned cvt_pk_bf16(float lo, float hi) { unsigned r; asm volatile("v_cvt_pk_bf16_f32 %0, %1, %2" : "=v"(r) : "v"(lo), "v"(hi)); return r; }
typedef float f32x2 __attribute__((ext_vector_type(2)));
typedef unsigned u32x2 __attribute__((ext_vector_type(2)));
__device__ __forceinline__ float sigm(float x) { return __builtin_amdgcn_rcpf(1.f + __builtin_amdgcn_exp2f(-1.4426950408889634f * x)); }
__device__ __forceinline__ float bf_lo(unsigned w) { return __builtin_bit_cast(float, w << 16); }
__device__ __forceinline__ float bf_hi(unsigned w) { return __builtin_bit_cast(float, w & 0xffff0000u); }
__device__ __forceinline__ u32x4 pack8(f32x4 a, f32x4 b) { u32x4 w; w.x = cvt_pk_bf16(a[0], a[1]); w.y = cvt_pk_bf16(a[2], a[3]); w.z = cvt_pk_bf16(b[0], b[1]); w.w = cvt_pk_bf16(b[2], b[3]); return w; }

struct EpiIn {
    static constexpr bool PERM = true, AFTER_DRAIN = false;
    bf16_t *MQ, *MK, *MV, *RQ, *RK, *RV, *RG, *SGA, *SGR; const float* rope_moba; const float* rope_ret; float* ksum; float qscale;
    __device__ __forceinline__ void operator()(const f32x4 (&acc)[2][2][4][2], const Unit& u, int wr, int wc, int fr, int fq) const {
        const int pn = u.pn; const int row0 = u.pm * BM + wr * 64 + fr;
        bf16_t* base; int ldc, colt, mode; float sc = 1.f; const float* tab = rope_moba;
        if (pn < 2)       { base = MQ;  ldc = 512;  colt = pn * 256;        mode = 1; sc = qscale; }
        else if (pn < 4)  { base = MK;  ldc = 512;  colt = (pn - 2) * 256;  mode = 1; }
        else if (pn < 6)  { base = MV;  ldc = 512;  colt = (pn - 4) * 256;  mode = 0; }
        else if (pn < 8)  { base = RQ;  ldc = 512;  colt = (pn - 6) * 256;  mode = 1; tab = rope_ret; }
        else if (pn < 10) { base = RK;  ldc = 512;  colt = (pn - 8) * 256;  mode = 1; tab = rope_ret; sc = 0.125f; }
        else if (pn < 14) { base = RV;  ldc = 1024; colt = (pn - 10) * 256; mode = 0; }
        else if (pn < 18) { base = RG;  ldc = 1024; colt = (pn - 14) * 256; mode = 2; }
        else if (pn < 22) { base = SGA; ldc = 1024; colt = (pn - 18) * 256; mode = 3; }
        else              { base = SGR; ldc = 1024; colt = (pn - 22) * 256; mode = 3; }
        const int col0 = colt + wc * 32 + 8 * fq;
        if (mode == 1) {
            const int g = 4 * (wc & 1) + fq; const bool isk = (pn == 2 || pn == 3);
            f32x4 ks[2][2];
#pragma unroll
            for (int bj = 0; bj < 2; ++bj)
#pragma unroll
                for (int n = 0; n < 2; ++n) ks[bj][n] = (f32x4){0.f, 0.f, 0.f, 0.f};
#pragma unroll
            for (int ai = 0; ai < 2; ++ai)
#pragma unroll
                for (int m = 0; m < 4; ++m) {
                    const int row = row0 + ai * HALF + m * 16; const int pos = row & 2047;
                    const f32x4 cs = *(const f32x4*)(tab + pos * 64 + 4 * g), sn = *(const f32x4*)(tab + pos * 64 + 32 + 4 * g);
                    bf16_t* rowp = base + (size_t)row * ldc + col0;
#pragma unroll
                    for (int bj = 0; bj < 2; ++bj) {
                        const f32x4 v0 = acc[ai][bj][m][0], v1 = acc[ai][bj][m][1];
                        const f32x4 o0 = (v0 * cs - v1 * sn) * sc, o1 = (v0 * sn + v1 * cs) * sc;
                        if (isk) { ks[bj][0] += o0; ks[bj][1] += o1; }
                        *(u32x4*)(rowp + bj * HALF) = pack8(o0, o1);
                    }
                }
            if (isk) {
#pragma unroll
                for (int bj = 0; bj < 2; ++bj)
#pragma unroll
                    for (int n = 0; n < 2; ++n)
#pragma unroll
                        for (int e = 0; e < 4; ++e) { float s = ks[bj][n][e]; s += __shfl_xor(s, 1); s += __shfl_xor(s, 2); s += __shfl_xor(s, 4); s += __shfl_xor(s, 8);
                            if (fr == 0) atomicAdd(ksum + (size_t)u.pm * 512 + col0 + bj * HALF + 4 * n + e, s); }
            }
        } else {
#pragma unroll
            for (int ai = 0; ai < 2; ++ai)
#pragma unroll
                for (int m = 0; m < 4; ++m) {
                    bf16_t* rowp = base + (size_t)(row0 + ai * HALF + m * 16) * ldc + col0;
#pragma unroll
                    for (int bj = 0; bj < 2; ++bj) {
                        f32x4 v0 = acc[ai][bj][m][0], v1 = acc[ai][bj][m][1];
                        if (mode >= 2) {
#pragma unroll
                            for (int e = 0; e < 4; ++e) { const float s0 = sigm(v0[e]), s1 = sigm(v1[e]); v0[e] = (mode == 2) ? v0[e] * s0 : s0; v1[e] = (mode == 2) ? v1[e] * s1 : s1; }
                        }
                        *(u32x4*)(rowp + bj * HALF) = pack8(v0, v1);
                    }
                }
        }
    }
};

template <bool ADD> struct EpiMerge {
    static constexpr bool PERM = true, AFTER_DRAIN = false;
    const bf16_t* gate; bf16_t* out;
    __device__ __forceinline__ void operator()(const f32x4 (&acc)[2][2][4][2], const Unit& u, int wr, int wc, int fr, int fq) const {
        const int row0 = u.pm * BM + wr * 64 + fr, col0 = u.pn * BM + wc * 32 + 8 * fq;
#pragma unroll
        for (int ai = 0; ai < 2; ++ai)
#pragma unroll
            for (int m = 0; m < 4; ++m) {
                const size_t off = (size_t)(row0 + ai * HALF + m * 16) * 1024 + col0;
#pragma unroll
                for (int bj = 0; bj < 2; ++bj) {
                    const u32x4 gw = *(const u32x4*)(gate + off + bj * HALF);
                    f32x4 v0 = acc[ai][bj][m][0], v1 = acc[ai][bj][m][1];
                    v0[0] *= bf_lo(gw.x); v0[1] *= bf_hi(gw.x); v0[2] *= bf_lo(gw.y); v0[3] *= bf_hi(gw.y);
                    v1[0] *= bf_lo(gw.z); v1[1] *= bf_hi(gw.z); v1[2] *= bf_lo(gw.w); v1[3] *= bf_hi(gw.w);
                    if (ADD) { const u32x4 pw = *(const u32x4*)(out + off + bj * HALF);
                        v0[0] += bf_lo(pw.x); v0[1] += bf_hi(pw.x); v0[2] += bf_lo(pw.y); v0[3] += bf_hi(pw.y);
                        v1[0] += bf_lo(pw.z); v1[1] += bf_hi(pw.z); v1[2] += bf_lo(pw.w); v1[3] += bf_hi(pw.w); }
                    *(u32x4*)(out + off + bj * HALF) = pack8(v0, v1);
                }
            }
    }
};

struct EpiRes {
    static constexpr bool PERM = false, AFTER_DRAIN = false;
    const float* xin; float* xo; const float* gvec  ; const float* lnw; const float* scv  ; bf16_t* A2; float* ss;
    __device__ __forceinline__ void operator()(const f32x4 (&acc)[2][2][4][2], const Unit& u, int wr, int wc, int fr, int fq) const {
        const int row0 = u.pm * BM + wr * 64 + fr, col0 = u.pn * BM + wc * 32 + 4 * fq; const int b = u.pm >> 3;
        f32x4 gv[2][2], we[2][2];
#pragma unroll
        for (int bj = 0; bj < 2; ++bj)
#pragma unroll
            for (int n = 0; n < 2; ++n) { const int c = col0 + bj * HALF + n * 16; gv[bj][n] = *(const f32x4*)(gvec + (size_t)b * 6144 + c);
                if (A2) { const f32x4 w = *(const f32x4*)(lnw + c), s = *(const f32x4*)(scv + (size_t)b * 6144 + c); we[bj][n] = w * (s + 1.0f); } else we[bj][n] = (f32x4){0.f, 0.f, 0.f, 0.f}; }
#pragma unroll
        for (int ai = 0; ai < 2; ++ai)
#pragma unroll
            for (int m = 0; m < 4; ++m) {
                const int row = row0 + ai * HALF + m * 16; const size_t off = (size_t)row * 1024 + col0; float q = 0.f;
#pragma unroll
                for (int bj = 0; bj < 2; ++bj)
#pragma unroll
                    for (int n = 0; n < 2; ++n) { const size_t o = off + bj * HALF + n * 16; const f32x4 xv = *(const f32x4*)(xin + o);
                        const f32x4 x1 = xv + gv[bj][n] * acc[ai][bj][m][n]; *(f32x4*)(xo + o) = x1; q += (x1[0] * x1[0] + x1[1] * x1[1]) + (x1[2] * x1[2] + x1[3] * x1[3]);
                        if (A2) { const f32x4 a = x1 * we[bj][n]; u32x2 w; w.x = cvt_pk_bf16(a[0], a[1]); w.y = cvt_pk_bf16(a[2], a[3]); *(u32x2*)(A2 + o) = w; } }
                q += __shfl_xor(q, 16); q += __shfl_xor(q, 32);
                if (fq == 0) atomicAdd(ss + row, q);
            }
    }
};

struct EpiFF1 {
    static constexpr bool PERM = true, AFTER_DRAIN = false;
    bf16_t* O; const float* c1; const float* ss; float eps;
    __device__ __forceinline__ void operator()(const f32x4 (&acc)[2][2][4][2], const Unit& u, int wr, int wc, int fr, int fq) const {
        const int row0 = u.pm * BM + wr * 64 + fr, col0 = u.pn * BM + wc * 32 + 8 * fq; const int b = u.pm >> 3;
        f32x4 cv[2][2];
#pragma unroll
        for (int bj = 0; bj < 2; ++bj)
#pragma unroll
            for (int n = 0; n < 2; ++n) cv[bj][n] = *(const f32x4*)(c1 + (size_t)b * 4096 + col0 + bj * HALF + 4 * n);
#pragma unroll
        for (int ai = 0; ai < 2; ++ai)
#pragma unroll
            for (int m = 0; m < 4; ++m) {
                const int row = row0 + ai * HALF + m * 16; const float rs = 1.0f / sqrtf(ss[row] * (1.0f / 1024.0f) + eps);
                bf16_t* rowp = O + (size_t)row * 4096 + col0;
#pragma unroll
                for (int bj = 0; bj < 2; ++bj) {
                    f32x4 v0 = acc[ai][bj][m][0] * rs + cv[bj][0], v1 = acc[ai][bj][m][1] * rs + cv[bj][1];
#pragma unroll
                    for (int e = 0; e < 4; ++e) { const float a = fmaxf(v0[e], 0.f), c = fmaxf(v1[e], 0.f); v0[e] = a * a; v1[e] = c * c; }
                    *(u32x4*)(rowp + bj * HALF) = pack8(v0, v1);
                }
            }
    }
};
template <class Epi, class Sched, bool ALIGN_EPI = false, bool SP2 = false>
__device__ __forceinline__ void gemm_phase(PG8_LAS unsigned char* lds, const Gemm g, const Sched& S, const Epi& E) {
    const int tid = threadIdx.x, wid = __builtin_amdgcn_readfirstlane(tid >> 6), lane = tid & 63, wr = wid >> 2, wc = wid & 3, fr = lane & 15, fq = lane >> 4;
    const int K = g.K, nt = K / BK;
    unsigned voffA[2], voffB[2];
#pragma unroll
    for (int i = 0; i < 2; ++i) { int R, C; stage_rc(tid * 16 + i * 8192, R, C); const int Rb = Epi::PERM ? ((R & ~31) + perm32(R & 31)) : R;
        voffA[i] = (unsigned)(R * K + C) * 2u; voffB[i] = (unsigned)(Rb * K + C) * 2u; }
    const size_t kstep = (size_t)(BK * 2);
    const size_t hstep = (size_t)HALF * K * 2;
    const size_t tstep = 2 * hstep;
    const unsigned ldsw = (unsigned)wid * 1024u;
    const int aoff = lds_byte(wr * 64 + fr, fq * 8), boff = lds_byte(wc * 32 + fr, fq * 8);
#define PG8_SA(b, h) (((b) * 2 + (h)) * HTB)
#define PG8_SB(b, h) ((4 + (b) * 2 + (h)) * HTB)
#define PG8_STAGE(bufoff, gbase, voff) do { _Pragma("unroll") for (int _i = 0; _i < 2; ++_i) \
        __builtin_amdgcn_global_load_lds((const unsigned*)((const char*)(gbase) + (voff)[_i]), (PG8_LAS unsigned*)(lds + (bufoff) + ldsw + _i * 8192), 16, 0, 0); } while (0)
#define PG8_LDA(dst, b, h) do { _Pragma("unroll") for (int m = 0; m < 4; ++m) _Pragma("unroll") for (int k = 0; k < 2; ++k) dst[m][k] = *(const PG8_LAS bf16x8*)(lds + PG8_SA(b, h) + aoff + m * 2048 + k * 1024); } while (0)
#define PG8_LDB(dst, b, h) do { _Pragma("unroll") for (int n = 0; n < 2; ++n) _Pragma("unroll") for (int k = 0; k < 2; ++k) dst[n][k] = *(const PG8_LAS bf16x8*)(lds + PG8_SB(b, h) + boff + n * 2048 + k * 1024); } while (0)
#define PG8_MMA(ai, bj, At, Bt) do { __builtin_amdgcn_s_setprio(1); _Pragma("unroll") for (int m = 0; m < 4; ++m) _Pragma("unroll") for (int n = 0; n < 2; ++n) _Pragma("unroll") for (int k = 0; k < 2; ++k) \
        acc[ai][bj][m][n] = __builtin_amdgcn_mfma_f32_16x16x32_bf16(Bt[n][k], At[m][k], acc[ai][bj][m][n], 0, 0, 0); __builtin_amdgcn_s_setprio(0); } while (0)
#define PG8_WAIT_V(n) asm volatile("s_waitcnt vmcnt(" #n ")" ::: "memory")
#define PG8_WAIT_L(n) asm volatile("s_waitcnt lgkmcnt(" #n ")" ::: "memory")
#define PG8_BAR __builtin_amdgcn_s_barrier()
#define PG8_SCHED __builtin_amdgcn_sched_barrier(0)
    Unit cur, nxt; int ui = 0;
    if (!S.next(0, cur)) return;
    f32x4 acc[2][2][4][2];
#pragma unroll
    for (int a = 0; a < 2; ++a)
#pragma unroll
        for (int b = 0; b < 2; ++b)
#pragma unroll
            for (int m = 0; m < 4; ++m)
#pragma unroll
                for (int n = 0; n < 2; ++n) acc[a][b][m][n] = (f32x4){0.f, 0.f, 0.f, 0.f};
    bf16x8 At[4][2], B0[2][2], B1[2][2];
    const char* cA = (const char*)g.A + (size_t)cur.pm * tstep; const char* cB = (const char*)g.Bt + (size_t)cur.pn * tstep;
    S.a_ready(cur);
    if constexpr (SP2) {
        PG8_STAGE(PG8_SB(0, 0), cB, voffB); PG8_STAGE(PG8_SB(0, 1), cB + hstep, voffB); PG8_STAGE(PG8_SA(0, 0), cA, voffA); PG8_STAGE(PG8_SA(0, 1), cA + hstep, voffA);
        if (wr == 1) PG8_BAR;
        PG8_WAIT_V(2); PG8_BAR;
        PG8_STAGE(PG8_SB(1, 0), cB + kstep, voffB); PG8_STAGE(PG8_SA(1, 0), cA + kstep, voffA); PG8_STAGE(PG8_SB(1, 1), cB + hstep + kstep, voffB);
        PG8_WAIT_V(6); PG8_BAR;
    } else {
        PG8_STAGE(PG8_SB(0, 0), cB, voffB); PG8_STAGE(PG8_SA(0, 0), cA, voffA); PG8_STAGE(PG8_SB(0, 1), cB + hstep, voffB); PG8_STAGE(PG8_SA(0, 1), cA + hstep, voffA);
        if (wr == 1) PG8_BAR;
        PG8_WAIT_V(4); PG8_BAR;
        PG8_STAGE(PG8_SB(1, 0), cB + kstep, voffB); PG8_STAGE(PG8_SA(1, 0), cA + kstep, voffA); PG8_STAGE(PG8_SB(1, 1), cB + hstep + kstep, voffB);
        PG8_WAIT_V(6); PG8_BAR;
    }
    for (;;) {
        const bool has_next = S.next(ui + 1, nxt);
        const char* nA = has_next ? (const char*)g.A + (size_t)nxt.pm * tstep : cA; const char* nB = has_next ? (const char*)g.Bt + (size_t)nxt.pn * tstep : cB;
        for (int t = 0; t < nt; t += 2) {
            const bool last = (t == nt - 2);
            const char* a1 = cA + (size_t)(t + 1) * kstep;
            const char* a2 = last ? nA : cA + (size_t)(t + 2) * kstep; const char* b2 = last ? nB : cB + (size_t)(t + 2) * kstep;
            const char* a3 = a2 + kstep; const char* b3 = b2 + kstep;
            if (last && has_next) S.a_ready(nxt);
            if constexpr (SP2) {
            PG8_LDB(B0, 0, 0); PG8_LDB(B1, 0, 1); PG8_SCHED; PG8_LDA(At, 0, 0); PG8_STAGE(PG8_SA(1, 1), a1 + hstep, voffA);
            PG8_WAIT_V(8); PG8_WAIT_L(0); PG8_BAR; PG8_MMA(0, 0, At, B0); PG8_MMA(0, 1, At, B1); PG8_BAR; PG8_SCHED;
            PG8_LDA(At, 0, 1); PG8_STAGE(PG8_SB(0, 0), b2, voffB); PG8_STAGE(PG8_SB(0, 1), b2 + hstep, voffB); PG8_STAGE(PG8_SA(0, 0), a2, voffA);
            PG8_WAIT_V(8); PG8_WAIT_L(0); PG8_BAR; PG8_MMA(1, 0, At, B0); PG8_MMA(1, 1, At, B1); PG8_BAR; PG8_SCHED;
            PG8_LDB(B0, 1, 0); PG8_LDB(B1, 1, 1); PG8_SCHED; PG8_LDA(At, 1, 0); PG8_STAGE(PG8_SA(0, 1), a2 + hstep, voffA);
            PG8_WAIT_V(8); PG8_WAIT_L(0); PG8_BAR; PG8_MMA(0, 0, At, B0); PG8_MMA(0, 1, At, B1); PG8_BAR; PG8_SCHED;
            PG8_LDA(At, 1, 1); PG8_STAGE(PG8_SB(1, 0), b3, voffB); PG8_STAGE(PG8_SB(1, 1), b3 + hstep, voffB); PG8_STAGE(PG8_SA(1, 0), a3, voffA);
            PG8_WAIT_V(8); PG8_WAIT_L(0); PG8_BAR; PG8_MMA(1, 0, At, B0); PG8_MMA(1, 1, At, B1); PG8_BAR; PG8_SCHED;
            } else {
            PG8_LDB(B0, 0, 0); PG8_SCHED; PG8_LDA(At, 0, 0); PG8_STAGE(PG8_SA(1, 1), a1 + hstep, voffA);
            PG8_WAIT_L(8); PG8_BAR; PG8_WAIT_L(0); PG8_MMA(0, 0, At, B0); PG8_BAR; PG8_SCHED;
            PG8_LDB(B1, 0, 1); PG8_STAGE(PG8_SB(0, 0), b2, voffB);
            PG8_BAR; PG8_WAIT_L(0); PG8_MMA(0, 1, At, B1); PG8_BAR;
            PG8_LDA(At, 0, 1); PG8_STAGE(PG8_SA(0, 0), a2, voffA);
            PG8_BAR; PG8_WAIT_L(0); PG8_MMA(1, 0, At, B0); PG8_BAR; PG8_SCHED;
            PG8_STAGE(PG8_SB(0, 1), b2 + hstep, voffB);
            PG8_WAIT_V(6); PG8_BAR; PG8_MMA(1, 1, At, B1); PG8_BAR;
            PG8_LDB(B0, 1, 0); PG8_SCHED; PG8_LDA(At, 1, 0); PG8_STAGE(PG8_SA(0, 1), a2 + hstep, voffA);
            PG8_WAIT_L(8); PG8_BAR; PG8_WAIT_L(0); PG8_MMA(0, 0, At, B0); PG8_BAR; PG8_SCHED;
            PG8_LDB(B1, 1, 1); PG8_STAGE(PG8_SB(1, 0), b3, voffB);
            PG8_BAR; PG8_WAIT_L(0); PG8_MMA(0, 1, At, B1); PG8_BAR;
            PG8_LDA(At, 1, 1); PG8_STAGE(PG8_SA(1, 0), a3, voffA);
            PG8_BAR; PG8_WAIT_L(0); PG8_MMA(1, 0, At, B0); PG8_BAR; PG8_SCHED;
            PG8_STAGE(PG8_SB(1, 1), b3 + hstep, voffB);
            PG8_WAIT_V(6); PG8_BAR; PG8_MMA(1, 1, At, B1); PG8_BAR;
            }
        }
        if constexpr (ALIGN_EPI) { if (wr == 0) PG8_BAR; }
        if constexpr (!Epi::AFTER_DRAIN) { E(acc, cur, wr, wc, fr, fq); S.done(cur); }
        if (!has_next) break;
#pragma unroll
        for (int a = 0; a < 2; ++a)
#pragma unroll
            for (int b = 0; b < 2; ++b)
#pragma unroll
                for (int m = 0; m < 4; ++m)
#pragma unroll
                    for (int n = 0; n < 2; ++n) acc[a][b][m][n] = (f32x4){0.f, 0.f, 0.f, 0.f};
        cur = nxt; cA = nA; cB = nB; ++ui;
        if constexpr (ALIGN_EPI) { if (wr == 1) PG8_BAR; }
    }
    PG8_WAIT_V(0);
    if constexpr (!ALIGN_EPI) { if (wr == 0) PG8_BAR; }
    PG8_BAR;
    if constexpr (Epi::AFTER_DRAIN) { E.fused(acc, cur, wr, wc, fr, fq, lds, wid, lane); S.done(cur); }
#undef PG8_SA
#undef PG8_SB
#undef PG8_STAGE
#undef PG8_LDA
#undef PG8_LDB
#undef PG8_MMA
#undef PG8_WAIT_V
#undef PG8_WAIT_L
#undef PG8_BAR
#undef PG8_SCHED
}
}
#define GAS __attribute__((address_space(1)))
#define LAS __attribute__((address_space(3)))
typedef unsigned short bf16;
typedef unsigned v4u __attribute__((ext_vector_type(4)));
typedef float f32x4 __attribute__((ext_vector_type(4)));
typedef short bf16x8 __attribute__((ext_vector_type(8)));
typedef GAS unsigned gu32;
typedef GAS unsigned long long gu64;
#define RLX_AGENT __ATOMIC_RELAXED, __HIP_MEMORY_SCOPE_AGENT
#define LDS_WAIT() asm volatile("s_waitcnt lgkmcnt(0)" ::: "memory")
#define VM_WAIT() asm volatile("s_waitcnt vmcnt(0)" ::: "memory")
__device__ __forceinline__ unsigned long long rt() { return __builtin_amdgcn_s_memrealtime(); }
__device__ __forceinline__ unsigned f2bf(float f) { unsigned u = __builtin_bit_cast(unsigned, f); return (u + 0x7fffu + ((u >> 16) & 1u)) >> 16; }
__device__ __forceinline__ unsigned pk2(float lo, float hi) { return f2bf(lo) | (f2bf(hi) << 16); }

#define XB_TMO      128
#define XB_XCNT(j)  (256  + 64 * (j))
#define XB_XSUB(j)  (1280 + 64 * (j))
#define XB_XGEN(j)  (2304 + 64 * (j))
#define XB_TOP      3328
#define XB_TOPGEN   3392
#define XCD_BAR_WORDS 3456
#define XB_SPIN_CAP (1u << 18)

__device__ __forceinline__ unsigned xb_ld(unsigned* p)              { return __hip_atomic_load(p, __ATOMIC_RELAXED, __HIP_MEMORY_SCOPE_AGENT); }
__device__ __forceinline__ unsigned xb_add(unsigned* p, unsigned v) { return __hip_atomic_fetch_add(p, v, __ATOMIC_RELAXED, __HIP_MEMORY_SCOPE_AGENT); }
__device__ __forceinline__ unsigned xb_xcc_id() { return (unsigned)__builtin_amdgcn_s_getreg((3 << 11) | 20) & 0xFu; }
#define XB_SPIN(cond, bar) do { unsigned _sp = 0; while (cond) { __builtin_amdgcn_s_sleep(1); \
    if ((++_sp & 255u) == 0u) { if (xb_ld(&(bar)[XB_TMO])) break; if (_sp > XB_SPIN_CAP) { atomicAdd(&(bar)[XB_TMO], 1u); break; } } } } while (0)

struct XcdBarrier {
    unsigned* bar; unsigned x;
    volatile LAS unsigned* st;
};

__device__ __forceinline__ XcdBarrier xcd_barrier_post(unsigned* bar, volatile LAS unsigned* st) {
    XcdBarrier b; b.bar = bar; b.x = xb_xcc_id(); b.st = st;
    if (threadIdx.x == 0) (void)xb_add(&bar[XB_XCNT(b.x)], 1u);
    return b;
}
__device__ __forceinline__ void xcd_barrier_complete(unsigned* bar, unsigned x, unsigned& nloc, unsigned& nx) {
    const unsigned G = gridDim.x * gridDim.y * gridDim.z;
    unsigned sum, cnt, mine, sp = 0u;
    for (;;) {
        sum = 0u; cnt = 0u; mine = 0u;
#pragma unroll
        for (unsigned j = 0; j < 16; ++j) { const unsigned c = xb_ld(&bar[XB_XCNT(j)]); sum += c; cnt += (c > 0u) ? 1u : 0u; mine = (j == x) ? c : mine; }
        if (sum == G) break;
        __builtin_amdgcn_s_sleep(1);
        if ((++sp & 255u) == 0u) { if (xb_ld(&bar[XB_TMO])) break; if (sp > XB_SPIN_CAP) { atomicAdd(&bar[XB_TMO], 1u); break; } }
    }
    nloc = mine > 0u ? mine : 1u; nx = cnt > 0u ? cnt : 1u;
}

__device__ __forceinline__ void xcd_barrier(const XcdBarrier& b) {
    asm volatile("s_waitcnt vmcnt(0)" ::: "memory");
    __syncthreads();
    if (threadIdx.x == 0) {
        unsigned* bar = b.bar;
        __builtin_amdgcn_s_waitcnt(0);
        unsigned nloc = b.st[0], nx = b.st[1];
        if (nloc == 0u) { xcd_barrier_complete(bar, b.x, nloc, nx); b.st[0] = nloc; b.st[1] = nx; }
        const unsigned old = xb_add(&bar[XB_XSUB(b.x)], 1u);
        const unsigned gen = old / nloc;
        if (old + 1u == (gen + 1u) * nloc) {
            __builtin_amdgcn_fence(__ATOMIC_RELEASE, "agent");
            asm volatile("s_waitcnt vmcnt(0)" ::: "memory");
            const unsigned og = xb_add(&bar[XB_TOP], 1u);
            const unsigned tg = og / nx;
            if (og + 1u == (tg + 1u) * nx) xb_add(&bar[XB_TOPGEN], 1u);
            else XB_SPIN(xb_ld(&bar[XB_TOPGEN]) == tg, bar);
            __builtin_amdgcn_fence(__ATOMIC_ACQUIRE, "agent");
            xb_add(&bar[XB_XGEN(b.x)], 1u);
            asm volatile("s_waitcnt vmcnt(0)" ::: "memory");
        } else {
            XB_SPIN(xb_ld(&bar[XB_XGEN(b.x)]) == gen, bar);
            __builtin_amdgcn_fence(__ATOMIC_ACQUIRE, "agent");
            asm volatile("s_waitcnt vmcnt(0)" ::: "memory");
        }
    }
    __syncthreads();
}

constexpr int NWAVES = 8;
constexpr int BATCH = 32, SEQ = 2048, D = 1024, FF = 4096, NIN = 6656, NADA = 6144;
constexpr int M = BATCH * SEQ;
constexpr float EPSN = 1e-6f;
constexpr float QSCALE = 0.125f * 1.4426950408889634f;
constexpr size_t KiB = 1024, MiB = 1u << 20;
constexpr size_t WS_CTL = 0;
constexpr size_t WS_ADA = 64 * KiB;
constexpr size_t WS_C1 = 832 * KiB;
constexpr size_t WS_KSUM = 1344 * KiB;
constexpr size_t WS_SS1 = 1856 * KiB;
constexpr size_t WS_SS2 = 2112 * KiB;
constexpr size_t ZERO_BYTES = 2560 * KiB;
constexpr size_t WS_ROPE = 3 * MiB;
constexpr size_t WS_WIN = 8 * MiB, WS_WMO = 21 * MiB, WS_WRO = 22 * MiB, WS_WOUT = 24 * MiB, WS_W1 = 26 * MiB, WS_W2 = 34 * MiB;
constexpr size_t WS_H = 48 * MiB;
constexpr size_t WS_MQ = 176 * MiB, WS_MK = 240 * MiB, WS_MV = 304 * MiB, WS_RQ = 368 * MiB, WS_RK = 432 * MiB;
constexpr size_t WS_RV = 496 * MiB, WS_RG = 624 * MiB, WS_SGA = 752 * MiB, WS_SGR = 880 * MiB;
constexpr size_t WS_A2 = 240 * MiB;
constexpr size_t WS_ACT = 496 * MiB;
constexpr size_t WS_END = 1008 * MiB;
constexpr int CW_BAR = 4096;
constexpr int RING_OFF = 0, RING_BYTES = 131072;
constexpr int LDSCTL_OFF = RING_BYTES, MISC_OFF = LDSCTL_OFF + 320;
constexpr int LDS_BYTES = 147456;

struct Frame {
    LAS unsigned char* lds;
    volatile LAS unsigned* MISC;
    int tid, lane, wave, vcu, G;
};

__device__ __forceinline__ float wave_sum(float v) {
#pragma unroll
    for (int o = 1; o < 64; o <<= 1) v += __shfl_xor(v, o);
    return v;
}
__device__ __forceinline__ int win_dst_row(int n) {
    const bool qk = (n < 1024) || (n >= 1536 && n < 2560);
    if (!qk) return n;
    const int d = n & 63, s = d >> 5, i = d & 31;
    return (n & ~63) + 8 * (i >> 2) + 4 * s + (i & 3);
}
template <bool PERMUTE>
__device__ __forceinline__ void p0_transpose_item(const float* W, int K, int N, bf16* WT, LAS float* scr, int item, int lane) {
    const int nblk = N / 32, kb = item / nblk, nb = item % nblk, k0 = 64 * kb, n0 = 32 * nb;
#pragma unroll 8
    for (int i = 0; i < 32; ++i) { const int kk = 2 * i + (lane >> 5); scr[kk * 33 + (lane & 31)] = W[(size_t)(k0 + kk) * N + n0 + (lane & 31)]; }
    LDS_WAIT(); asm volatile("" ::: "memory");
    const int c = lane & 7;
#pragma unroll
    for (int j = 0; j < 4; ++j) { const int n = (lane >> 3) + 8 * j; const LAS float* s = scr + (8 * c) * 33 + n;
        v4u o; o.x = pk2(s[0 * 33], s[1 * 33]); o.y = pk2(s[2 * 33], s[3 * 33]); o.z = pk2(s[4 * 33], s[5 * 33]); o.w = pk2(s[6 * 33], s[7 * 33]);
        const int drow = PERMUTE ? win_dst_row(n0 + n) : (n0 + n);
        *(GAS v4u*)(WT + (size_t)drow * K + k0 + 8 * c) = o; }
    LDS_WAIT(); asm volatile("" ::: "memory");
}
typedef float f32x16 __attribute__((ext_vector_type(16)));
template <bool SILU>
__device__ __forceinline__ void gemv32_item(const float* in, int ldin, const float* W, int N, const float* bias, float* out, int ldout, int k0, int KS, int n0, int lane) {
    const int r = lane & 31, hh = lane >> 5;
    f32x16 acc;
#pragma unroll
    for (int i = 0; i < 16; ++i) acc[i] = 0.f;
#pragma unroll 8
    for (int kk = 0; kk < KS; kk += 2) {
        float a = in[(size_t)r * ldin + k0 + kk + hh]; if (SILU) a = a / (1.0f + __expf(-a));
        const float w = W[(size_t)(k0 + kk + hh) * N + n0 + r];
        acc = __builtin_amdgcn_mfma_f32_32x32x2f32(a, w, acc, 0, 0, 0);
    }
    const float bv = (bias && k0 == 0) ? bias[n0 + r] : 0.f;
#pragma unroll
    for (int i = 0; i < 16; ++i) { const int brow = (i & 3) + 8 * (i >> 2) + 4 * hh; atomicAdd(out + (size_t)brow * ldout + n0 + r, acc[i] + bv); }
}
__device__ __forceinline__ void sincos_d(double ang, float& sn, float& cs) {
    const double k = rint(ang * 0.63661977236758134308);
    const double t = (ang - k * 1.57079632679489655800) - k * 6.12323399573676603587e-17, t2 = t * t;
    double s = -1.0 / 6227020800.0; s = s * t2 + 1.0 / 39916800.0; s = s * t2 - 1.0 / 362880.0; s = s * t2 + 1.0 / 5040.0; s = s * t2 - 1.0 / 120.0; s = s * t2 + 1.0 / 6.0; s = t - t * t2 * s;
    double c = 1.0 / 479001600.0; c = c * t2 - 1.0 / 3628800.0; c = c * t2 + 1.0 / 40320.0; c = c * t2 - 1.0 / 720.0; c = c * t2 + 1.0 / 24.0; c = c * t2 - 0.5; c = 1.0 + t2 * c;
    const int q = (int)((long long)k & 3);
    const double ss = (q == 0) ? s : (q == 1) ? c : (q == 2) ? -s : -c;
    const double cc = (q == 0) ? c : (q == 1) ? -s : (q == 2) ? -c : s;
    sn = (float)ss; cs = (float)cc;
}

struct Ptrs {
    const float *x, *c, *ln1w, *ln2w, *wada, *bada, *win, *gnw, *wmo, *wro, *wout, *wff1, *wff2, *fnw;
    float* out; unsigned char* ws;
};

__device__ __forceinline__ void phase0(Frame& F, const Ptrs& P) {
    const int gw = F.vcu * NWAVES + F.wave, NGW = F.G * NWAVES;
    for (int gt = gw * 64 + F.lane; gt < 2 * 2048 * 32; gt += NGW * 64) {
        const int tb = gt >> 16, pos = (gt >> 5) & 2047, f = gt & 31;
        const double e = (tb == 0) ? (double)f * (1.0 / 32.0) : (double)f * (1.0 / 31.0);
        const double inv = exp2(-e * 13.28771237954945);
        float sn, cs; sincos_d((double)pos * inv, sn, cs);
        float* tab = (float*)(P.ws + WS_ROPE) + (size_t)tb * 2048 * 64 + pos * 64;
        tab[f] = cs; tab[32 + f] = sn;
    }
    for (int it = gw; it < 8 * 192; it += NGW) { const int ks = it / 192, cg = it % 192;
        gemv32_item<true>(P.c, D, P.wada, NADA, P.bada, (float*)(P.ws + WS_ADA), NADA, ks * 128, 128, cg * 32, F.lane); }
    LAS float* scr = (LAS float*)(F.lds + RING_OFF + F.wave * 16384);
    constexpr int I_IN = (D / 64) * (NIN / 32), I_MO = (512 / 64) * (D / 32), I_RO = (D / 64) * (D / 32), I_OUT = I_RO, I_1 = (D / 64) * (FF / 32), I_2 = (FF / 64) * (D / 32);
    constexpr int NITEMS = I_IN + I_MO + I_RO + I_OUT + I_1 + I_2;
    for (int it = gw; it < NITEMS; it += NGW) {
        int r = it;
        if (r < I_IN) { p0_transpose_item<true>(P.win, D, NIN, (bf16*)(P.ws + WS_WIN), scr, r, F.lane); continue; } r -= I_IN;
        if (r < I_MO) { p0_transpose_item<false>(P.wmo, 512, D, (bf16*)(P.ws + WS_WMO), scr, r, F.lane); continue; } r -= I_MO;
        if (r < I_RO) { p0_transpose_item<false>(P.wro, D, D, (bf16*)(P.ws + WS_WRO), scr, r, F.lane); continue; } r -= I_RO;
        if (r < I_OUT) { p0_transpose_item<false>(P.wout, D, D, (bf16*)(P.ws + WS_WOUT), scr, r, F.lane); continue; } r -= I_OUT;
        if (r < I_1) { p0_transpose_item<false>(P.wff1, D, FF, (bf16*)(P.ws + WS_W1), scr, r, F.lane); continue; } r -= I_1;
        p0_transpose_item<false>(P.wff2, FF, D, (bf16*)(P.ws + WS_W2), scr, r, F.lane);
    }
}
__device__ __forceinline__ void phase1(Frame& F, const Ptrs& P) {
    const int gw = F.vcu * NWAVES + F.wave, NGW = F.G * NWAVES;
    const float* ada = (const float*)(P.ws + WS_ADA);
    for (int it = gw; it < 8 * 128; it += NGW) { const int ks = it / 128, cg = it % 128;
        gemv32_item<false>(ada + 3 * D, NADA, P.wff1, FF, nullptr, (float*)(P.ws + WS_C1), FF, ks * 128, 128, cg * 32, F.lane); }
    bf16* H = (bf16*)(P.ws + WS_H);
    for (int r0 = gw * 32; r0 < M; r0 += NGW * 32) {
        const int b = r0 >> 11;
        f32x4 we[4], sh[4];
#pragma unroll
        for (int j = 0; j < 4; ++j) { const int c = 4 * F.lane + 256 * j; const f32x4 w = *(const f32x4*)(P.ln1w + c), s = *(const f32x4*)(ada + (size_t)b * NADA + D + c);
            we[j] = w * (s + 1.0f); sh[j] = *(const f32x4*)(ada + (size_t)b * NADA + c); }
        for (int rr = 0; rr < 32; rr += 2) {
            f32x4 v[2][4]; float s2[2] = {0.f, 0.f};
#pragma unroll
            for (int q = 0; q < 2; ++q) { const GAS f32x4* xr = (const GAS f32x4*)(P.x + (size_t)(r0 + rr + q) * D) + F.lane;
#pragma unroll
                for (int j = 0; j < 4; ++j) v[q][j] = xr[64 * j]; }
#pragma unroll
            for (int q = 0; q < 2; ++q) {
#pragma unroll
                for (int j = 0; j < 4; ++j) s2[q] += (v[q][j].x * v[q][j].x + v[q][j].y * v[q][j].y) + (v[q][j].z * v[q][j].z + v[q][j].w * v[q][j].w);
                const float rstd = 1.0f / sqrtf(wave_sum(s2[q]) * (1.0f / D) + EPSN);
                GAS unsigned long long* o8 = (GAS unsigned long long*)(H + (size_t)(r0 + rr + q) * D) + F.lane;
#pragma unroll
                for (int j = 0; j < 4; ++j) { const f32x4 y = v[q][j] * rstd * we[j] + sh[j];
                    o8[64 * j] = (unsigned long long)pk2(y.x, y.y) | ((unsigned long long)pk2(y.z, y.w) << 32); }
            }
        }
    }
}
__device__ __forceinline__ void phase8(Frame& F, const Ptrs& P) {
    const int gw = F.vcu * NWAVES + F.wave, NGW = F.G * NWAVES;
    const float* ss2 = (const float*)(P.ws + WS_SS2);
    f32x4 fw[4];
#pragma unroll
    for (int j = 0; j < 4; ++j) fw[j] = *(const f32x4*)(P.fnw + 4 * F.lane + 256 * j);
    for (int r0 = gw * 32; r0 < M; r0 += NGW * 32) {
        for (int rr = 0; rr < 32; rr += 2) {
            f32x4 v[2][4];
#pragma unroll
            for (int q = 0; q < 2; ++q) { const GAS f32x4* xr = (const GAS f32x4*)(P.out + (size_t)(r0 + rr + q) * D) + F.lane;
#pragma unroll
                for (int j = 0; j < 4; ++j) v[q][j] = xr[64 * j]; }
#pragma unroll
            for (int q = 0; q < 2; ++q) { const float rstd = 1.0f / sqrtf(ss2[r0 + rr + q] * (1.0f / D) + EPSN);
                GAS f32x4* xo = (GAS f32x4*)(P.out + (size_t)(r0 + rr + q) * D) + F.lane;
#pragma unroll
                for (int j = 0; j < 4; ++j) xo[64 * j] = v[q][j] * rstd * fw[j]; }
        }
    }
}

__device__ __forceinline__ void unpack8(const v4u w, float* f) {
    f[0] = __builtin_bit_cast(float, w.x << 16); f[1] = __builtin_bit_cast(float, w.x & 0xffff0000u); f[2] = __builtin_bit_cast(float, w.y << 16); f[3] = __builtin_bit_cast(float, w.y & 0xffff0000u);
    f[4] = __builtin_bit_cast(float, w.z << 16); f[5] = __builtin_bit_cast(float, w.z & 0xffff0000u); f[6] = __builtin_bit_cast(float, w.w << 16); f[7] = __builtin_bit_cast(float, w.w & 0xffff0000u);
}
__device__ __forceinline__ unsigned moba_select(const float (&g)[7], int qb) {
    unsigned sel = 0;
#pragma unroll
    for (int j = 0; j < 7; ++j) { int cnt = 0;
#pragma unroll
        for (int k = 0; k < 7; ++k) if (k != j) cnt += (k < qb) && ((g[k] > g[j]) || (g[k] == g[j] && k < j));
        if (j < qb && cnt < 3) sel |= 1u << j; }
    return sel;
}
__device__ void naive_moba(Frame& F, const Ptrs& P) {
    const bf16* MQ = (const bf16*)(P.ws + WS_MQ); const bf16* MK = (const bf16*)(P.ws + WS_MK); const bf16* MV = (const bf16*)(P.ws + WS_MV); bf16* O = (bf16*)(P.ws + WS_MQ);
    const float* ksum = (const float*)(P.ws + WS_KSUM);
    const int gt0 = (F.vcu * NWAVES + F.wave) * 64 + F.lane, NT = F.G * NWAVES * 64;
    for (int idx = gt0; idx < BATCH * 8 * SEQ; idx += NT) {
        const int s = idx & 2047, bh = idx >> 11, b = bh >> 3, h = bh & 7, qb = s >> 8; const size_t row = (size_t)b * SEQ + s;
        float q[64];
#pragma unroll
        for (int i = 0; i < 8; ++i) unpack8(*(const v4u*)(MQ + row * 512 + h * 64 + 8 * i), q + 8 * i);
        float g[7];
#pragma unroll
        for (int j = 0; j < 7; ++j) { float a = 0.f; if (j < qb) { const float* kp = ksum + (size_t)(b * 8 + j) * 512 + h * 64;
#pragma unroll
                for (int d = 0; d < 64; ++d) a += q[d] * kp[d]; } g[j] = a; }
        const unsigned sel = moba_select(g, qb);
        float mx = -INFINITY, l = 0.f; float o[64];
#pragma unroll
        for (int d = 0; d < 64; ++d) o[d] = 0.f;
        for (int it = 0; it <= qb; ++it) {
            const int j = (it == 0) ? qb : it - 1; if (it > 0 && !((sel >> j) & 1u)) continue;
            const int nk = (it == 0) ? (s & 255) + 1 : 256;
#pragma unroll 1
            for (int k = 0; k < nk; ++k) {
                const size_t kr = (size_t)b * SEQ + j * 256 + k; float a = 0.f;
#pragma unroll
                for (int c = 0; c < 8; ++c) { float kf[8]; unpack8(*(const v4u*)(MK + kr * 512 + h * 64 + 8 * c), kf);
#pragma unroll
                    for (int d = 0; d < 8; ++d) a += q[8 * c + d] * kf[d]; }
                if (a > mx) { const float f = __builtin_amdgcn_exp2f(mx - a); mx = a; l *= f;
#pragma unroll
                    for (int d = 0; d < 64; ++d) o[d] *= f; }
                const float p = __builtin_amdgcn_exp2f(a - mx); l += p;
#pragma unroll
                for (int c = 0; c < 8; ++c) { float vf[8]; unpack8(*(const v4u*)(MV + kr * 512 + h * 64 + 8 * c), vf);
#pragma unroll
                    for (int d = 0; d < 8; ++d) o[8 * c + d] += p * vf[d]; }
            }
        }
        const float rl = 1.0f / l;
#pragma unroll
        for (int i = 0; i < 8; ++i) { v4u w; w.x = pk2(o[8 * i] * rl, o[8 * i + 1] * rl); w.y = pk2(o[8 * i + 2] * rl, o[8 * i + 3] * rl); w.z = pk2(o[8 * i + 4] * rl, o[8 * i + 5] * rl); w.w = pk2(o[8 * i + 6] * rl, o[8 * i + 7] * rl);
            *(v4u*)(O + row * 512 + h * 64 + 8 * i) = w; }
    }
}
__device__ void naive_ret(Frame& F, const Ptrs& P) {
    const bf16* RQ = (const bf16*)(P.ws + WS_RQ); const bf16* RK = (const bf16*)(P.ws + WS_RK); const bf16* RV = (const bf16*)(P.ws + WS_RV); bf16* RG = (bf16*)(P.ws + WS_RG);
    LAS float* Qs = (LAS float*)(F.lds + RING_OFF); LAS float* Ks = Qs + 1024; LAS float* Vs = Ks + 1024; LAS float* Pt = Vs + 2048;
    const int t = F.tid, e = t & 127, grp = t >> 7, d0 = grp * 16;
    for (int u = F.vcu; u < BATCH * 8; u += F.G) {
        const int b = u >> 3, h = u & 7; const float gam = 1.0f - exp2f(-5.0f - (float)h);
        float S[16];
#pragma unroll
        for (int d = 0; d < 16; ++d) S[d] = 0.f;
        __syncthreads();
        for (int tb = 0; tb < SEQ / 16; ++tb) {
            const size_t rbase = (size_t)b * SEQ + tb * 16;
            { const int idx = 2 * t, tok = idx >> 6, d = idx & 63;
              const unsigned wq = *(const unsigned*)(RQ + (rbase + tok) * 512 + h * 64 + d), wk = *(const unsigned*)(RK + (rbase + tok) * 512 + h * 64 + d);
              Qs[idx] = __builtin_bit_cast(float, wq << 16); Qs[idx + 1] = __builtin_bit_cast(float, wq & 0xffff0000u);
              Ks[idx] = __builtin_bit_cast(float, wk << 16); Ks[idx + 1] = __builtin_bit_cast(float, wk & 0xffff0000u);
              const int iv = 4 * t, tv = iv >> 7, ev = iv & 127; const unsigned long long wv = *(const unsigned long long*)(RV + (rbase + tv) * 1024 + h * 128 + ev);
              const unsigned w0 = (unsigned)wv, w1 = (unsigned)(wv >> 32);
              Vs[iv] = __builtin_bit_cast(float, w0 << 16); Vs[iv + 1] = __builtin_bit_cast(float, w0 & 0xffff0000u); Vs[iv + 2] = __builtin_bit_cast(float, w1 << 16); Vs[iv + 3] = __builtin_bit_cast(float, w1 & 0xffff0000u); }
            __syncthreads();
            for (int tok = 0; tok < 16; ++tok) { const float v = Vs[tok * 128 + e]; float a = 0.f;
#pragma unroll
                for (int d = 0; d < 16; ++d) { S[d] = gam * S[d] + Ks[tok * 64 + d0 + d] * v; a += Qs[tok * 64 + d0 + d] * S[d]; }
                Pt[(tok * 4 + grp) * 128 + e] = a; }
            __syncthreads();
#pragma unroll
            for (int q = 0; q < 2; ++q) { const int tok = 2 * F.wave + q; const size_t row = rbase + tok;
                float o0 = 0.f, o1 = 0.f;
#pragma unroll
                for (int gI = 0; gI < 4; ++gI) { o0 += Pt[(tok * 4 + gI) * 128 + F.lane]; o1 += Pt[(tok * 4 + gI) * 128 + 64 + F.lane]; }
                const float mu = wave_sum(o0 + o1) * (1.0f / 128.0f); const float a0 = o0 - mu, a1 = o1 - mu;
                const float var = wave_sum(a0 * a0 + a1 * a1) * (1.0f / 128.0f); const float rs = 1.0f / sqrtf(var + EPSN);
                bf16* gp = RG + row * 1024 + h * 128;
                const float g0 = __builtin_bit_cast(float, (unsigned)gp[F.lane] << 16), g1 = __builtin_bit_cast(float, (unsigned)gp[64 + F.lane] << 16);
                gp[F.lane] = (bf16)f2bf(a0 * rs * P.gnw[h * 128 + F.lane] * g0); gp[64 + F.lane] = (bf16)f2bf(a1 * rs * P.gnw[h * 128 + 64 + F.lane] * g1); }
        }
    }
}
#include <hip/hip_bf16.h>
#include <cmath>
namespace attn_body {
using bf16=__hip_bfloat16;
using bf16x8=__attribute__((ext_vector_type(8)))short;
using s16x4=__attribute__((ext_vector_type(4)))short;
using f32x16=__attribute__((ext_vector_type(16)))float;
using u32x4=__attribute__((ext_vector_type(4)))unsigned;
constexpr int BATCH=32,NHEAD=8,SEQ=2048,D=64,DM=NHEAD*D;
constexpr int NW=8,QBLK=32,QB=QBLK*NW,KVBLK=64,NQB=SEQ/QB;
constexpr int ATTN_PITCH=DM, ATTN_UNIT_ROWS=QB;
__device__ __forceinline__ int crow(int r,int hi){return (r&3)+8*(r>>2)+4*hi;}
#define SBAR() __builtin_amdgcn_sched_barrier(0)
__device__ __forceinline__ void cmask(f32x16&p0,f32x16&p1,int jb,int qrel,int hi){
  const float NEG=-INFINITY; int kb=64*jb+4*hi;
  #pragma unroll
  for(int r=0;r<16;++r){int kv=kb+(r&3)+8*(r>>2); if(kv>qrel)p0[r]=NEG; if(kv+32>qrel)p1[r]=NEG;}
}

constexpr int NSLOT=3, SLOTB=8192;
constexpr int LDS_K=0, LDS_V=NSLOT*SLOTB, LDS_WS=2*NSLOT*SLOTB, LDS_OST=LDS_WS+NW*64*4, LDS_BYTES=LDS_OST+NW*4096;
constexpr float C2=0.125f*1.4426950408889634f;
__device__ __forceinline__ void glds16(const void*gsrc,unsigned lds_dst){unsigned keep;
  asm volatile("s_mov_b32 %0, m0\n\ts_mov_b32 m0, %2\n\ts_nop 0\n\tglobal_load_lds_dwordx4 %1, off\n\ts_mov_b32 m0, %0":"=&s"(keep):"v"(gsrc),"s"(lds_dst):"memory");}
__device__ __forceinline__ float max3f(float a,float b,float c){float r;asm("v_max3_f32 %0, %1, %2, %3":"=v"(r):"v"(a),"v"(b),"v"(c));return r;}
__device__ __forceinline__ float max2f(float a,float b){float r;asm("v_max_f32_e32 %0, %1, %2":"=v"(r):"v"(a),"v"(b));return r;}
__device__ __forceinline__ float fadd_s(float a,float b){float r;asm("v_add_f32_e32 %0, %1, %2":"=v"(r):"v"(a),"v"(b));return r;}
__device__ __forceinline__ float fsub_s(float a,float b){float r;asm("v_sub_f32_e32 %0, %1, %2":"=v"(r):"v"(a),"v"(b));return r;}
typedef float f32x2_t __attribute__((ext_vector_type(2))); typedef __bf16 bf16x2_t __attribute__((ext_vector_type(2)));
__device__ __forceinline__ unsigned cvtpk_s(float lo,float hi){f32x2_t v={lo,hi};bf16x2_t b=__builtin_convertvector(v,bf16x2_t);return __builtin_bit_cast(unsigned,b);}
#define WAIT_BAR(N) asm volatile("s_waitcnt vmcnt(" #N ") lgkmcnt(0)\n\ts_barrier":::"memory")

__device__ __forceinline__ void qkt(f32x16&p0,f32x16&p1,const char*Kslot,const bf16x8*qr,const f32x16&negm,int r32,int hi){
  const char*kb=Kslot+hi*1024+r32*16;
  #pragma unroll
  for(int d0=0;d0<4;++d0){
    const bf16x8 b0=*reinterpret_cast<const bf16x8*>(kb+d0*2048);
    const bf16x8 b1=*reinterpret_cast<const bf16x8*>(kb+d0*2048+512);
    if(d0==0){p0=__builtin_amdgcn_mfma_f32_32x32x16_bf16(b0,qr[0],negm,0,0,0);p1=__builtin_amdgcn_mfma_f32_32x32x16_bf16(b1,qr[0],negm,0,0,0);}
    else{p0=__builtin_amdgcn_mfma_f32_32x32x16_bf16(b0,qr[d0],p0,0,0,0);p1=__builtin_amdgcn_mfma_f32_32x32x16_bf16(b1,qr[d0],p1,0,0,0);}}
}
typedef __attribute__((address_space(3))) const char* lds_cptr;
typedef short v4i16_t __attribute__((ext_vector_type(4)));
__device__ __forceinline__ void kload8(bf16x8*kf,lds_cptr kp){
  kf[0]=*(const __attribute__((address_space(3))) bf16x8*)(kp);      kf[1]=*(const __attribute__((address_space(3))) bf16x8*)(kp+512);
  kf[2]=*(const __attribute__((address_space(3))) bf16x8*)(kp+2048); kf[3]=*(const __attribute__((address_space(3))) bf16x8*)(kp+2560);
  kf[4]=*(const __attribute__((address_space(3))) bf16x8*)(kp+4096); kf[5]=*(const __attribute__((address_space(3))) bf16x8*)(kp+4608);
  kf[6]=*(const __attribute__((address_space(3))) bf16x8*)(kp+6144); kf[7]=*(const __attribute__((address_space(3))) bf16x8*)(kp+6656);
}
__device__ __forceinline__ void kload2(bf16x8*kf,lds_cptr kp,int j){ kf[2*j]=*(const __attribute__((address_space(3))) bf16x8*)(kp+j*2048); kf[2*j+1]=*(const __attribute__((address_space(3))) bf16x8*)(kp+j*2048+512); }
__device__ __forceinline__ s16x4 vtr(lds_cptr p){ return __builtin_bit_cast(s16x4,__builtin_amdgcn_ds_read_tr16_b64_v4i16((__attribute__((address_space(3))) v4i16_t*)p)); }
__device__ __forceinline__ float rowmax(const f32x16&p0,const f32x16&p1){
  float a=max3f(p0[0],p0[1],p1[0]),b=max3f(p0[2],p0[3],p1[1]);a=max3f(a,p1[2],p1[3]);
  #pragma unroll
  for(int r=4;r<16;r+=4){a=max3f(a,p0[r],p0[r+1]);b=max3f(b,p0[r+2],p0[r+3]);a=max3f(a,p1[r],p1[r+1]);b=max3f(b,p1[r+2],p1[r+3]);}
  const float m=max2f(a,b);
  auto rr=__builtin_amdgcn_permlane32_swap(__float_as_uint(m),__float_as_uint(m),false,false);
  return max2f(__uint_as_float(rr[0]),__uint_as_float(rr[1]));
}
__device__ __forceinline__ void pv(f32x16*o,int vb,bf16x8 pa0,bf16x8 pa1,bf16x8 pa2,bf16x8 pa3){
  #pragma unroll
  for(int d0=0;d0<2;++d0){s16x4 lo[4],hi[4];
    #pragma unroll
    for(int ks=0;ks<4;++ks){
      asm volatile("ds_read_b64_tr_b16 %0,%1 offset:%c2":"=&v"(lo[ks]):"v"(vb),"i"(d0*4096+ks*1024):"memory");
      asm volatile("ds_read_b64_tr_b16 %0,%1 offset:%c2":"=&v"(hi[ks]):"v"(vb),"i"(d0*4096+ks*1024+512):"memory");}
    asm volatile("s_waitcnt lgkmcnt(0)":::"memory");SBAR();
    #define PK(k) (bf16x8){lo[k][0],lo[k][1],lo[k][2],lo[k][3],hi[k][0],hi[k][1],hi[k][2],hi[k][3]}
    o[d0]=__builtin_amdgcn_mfma_f32_32x32x16_bf16(pa0,PK(0),o[d0],0,0,0);
    o[d0]=__builtin_amdgcn_mfma_f32_32x32x16_bf16(pa1,PK(1),o[d0],0,0,0);
    o[d0]=__builtin_amdgcn_mfma_f32_32x32x16_bf16(pa2,PK(2),o[d0],0,0,0);
    o[d0]=__builtin_amdgcn_mfma_f32_32x32x16_bf16(pa3,PK(3),o[d0],0,0,0);
    #undef PK
  }
}

#ifndef ATTN_STORE16
#define ATTN_STORE16(p,v) (*(u32x4*)(p)=(v))
#endif
template<int THRL> __device__ __forceinline__ void attn_unit(int b,int h,int qb,const bf16*Q,const bf16*__restrict__ K,const bf16*__restrict__ V,bf16*O,char*shm,const float*ksum){
  int tid_=threadIdx.x; asm volatile("":"+v"(tid_));
  const int tid=tid_,lane=tid&63,r32=lane&31,hi=lane>>5; const int wid=__builtin_amdgcn_readfirstlane(tid>>6);
  const long rowbase=(long)b*SEQ; const int q0=qb*QB;
  const bf16*Qw=Q+(rowbase+q0+wid*QBLK)*DM+h*D;
  const bf16*Kh=K+rowbase*DM+h*D,*Vh=V+rowbase*DM+h*D;
  const unsigned lds0=(unsigned)(uintptr_t)shm;
  float*wsf=(float*)(shm+LDS_WS)+wid*64;
  const bf16*ksrc=Kh+(long)lane*DM+wid*8;
  const bf16*vsrc=Vh+(long)(16*(wid&3)+(lane>>2))*DM+(wid>>2)*32+(lane&3)*8;
  const unsigned kdst=lds0+LDS_K+wid*1024, vdst=lds0+LDS_V+wid*1024;
  #define KT(t) (((t)<4)?(4*qb+(t)):((t)-4))
  #define DMA_K(t,slot) glds16(ksrc+(long)KT(t)*KVBLK*DM,(unsigned)__builtin_amdgcn_readfirstlane(kdst+(slot)))
  #define DMA_V(t,slot) glds16(vsrc+(long)KT(t)*KVBLK*DM,(unsigned)__builtin_amdgcn_readfirstlane(vdst+(slot)))
  const int vb0=(int)(lds0+LDS_V)+((lane>>4)&1)*32+(lane&3)*8+(4*hi+((lane&15)>>2))*64;
  const char*Kbase=shm+LDS_K; bf16x8 kf[8];
  const lds_cptr shm3=(lds_cptr)shm; const lds_cptr kp0=shm3+LDS_K+hi*1024+r32*16; const lds_cptr vp0=shm3+LDS_V+((lane>>4)&1)*32+(lane&3)*8+(4*hi+((lane&15)>>2))*64;
  const int NT=(q0+QB)/KVBLK;
  DMA_K(0,0);DMA_V(0,0);DMA_K(1,SLOTB);
  bf16x8 qr[4];
  #pragma unroll
  for(int d0=0;d0<4;++d0)qr[d0]=*reinterpret_cast<const bf16x8*>(&Qw[(long)r32*DM+d0*16+hi*8]);

  unsigned selbits=0u;
  if(qb>0){ float gsc[7]; typedef float f32x4v __attribute__((ext_vector_type(4)));
    #pragma unroll
    for(int k=0;k<7;++k)gsc[k]=0.f;
    #pragma unroll 1
    for(int j=0;j<qb;++j){ float a=0.f; const float*kp=ksum+((long)(b*8+j))*512+h*64+hi*8;
      #pragma unroll
      for(int d0=0;d0<4;++d0){ const f32x4v k0=*(const f32x4v*)(kp+d0*16), k1=*(const f32x4v*)(kp+d0*16+4);
        #pragma unroll
        for(int e=0;e<4;++e){ a+=__builtin_bit_cast(float,((unsigned)(unsigned short)qr[d0][e])<<16)*k0[e]; a+=__builtin_bit_cast(float,((unsigned)(unsigned short)qr[d0][4+e])<<16)*k1[e]; } }
      a+=__shfl_xor(a,32);
      #pragma unroll
      for(int k=0;k<7;++k)gsc[k]=(k==j)?a:gsc[k]; }
    selbits=::moba_select(gsc,qb); }
  float mhat=0.f,l_reg=0.f;f32x16 o[2];f32x16 negm;{float z_;asm volatile("v_mov_b32 %0, 0":"=v"(z_));
    _Pragma("unroll") for(int r=0;r<16;++r){o[0][r]=z_;o[1][r]=z_;negm[r]=z_;}}asm volatile("":"+v"(negm));
  const int qrel=wid*QBLK+r32;
  #define CMASK(P0,P1,t) do{ if((t)<4){cmask(P0,P1,(t),qrel,hi);} else { const float ad_=((selbits>>(((t)-4)>>2))&1u)?0.f:-INFINITY; _Pragma("unroll") for(int r_=0;r_<16;++r_){P0[r_]+=ad_;P1[r_]+=ad_;} } }while(0)
  bool resc=false;
  #define START(P0,P1) do{ const float rm=rowmax(P0,P1); resc=false; \
    { const float dl=rm; mhat=fadd_s(mhat,dl); \
      _Pragma("unroll") for(int r=0;r<16;++r){P0[r]=fsub_s(P0[r],dl);P1[r]=fsub_s(P1[r],dl);} \
      _Pragma("unroll") for(int r=0;r<16;++r)negm[r]=-mhat; asm volatile("":"+v"(negm)); } \
    _Pragma("unroll") for(int r=0;r<16;++r)P0[r]=__builtin_amdgcn_exp2f(P0[r]); }while(0)
  #define RESC() do{ if(resc){ asm volatile("s_waitcnt lgkmcnt(0)":::"memory"); \
      _Pragma("unroll") for(int d_=0;d_<2;++d_) _Pragma("unroll") for(int r=0;r<16;++r)o[d_][r]*=wsf[crow(r,hi)]; } }while(0)
  f32x16 pA0,pA1,pB0,pB1;
  int sl_prev=0,sl_cur=0,sl_next=SLOTB;
  #define ROT() do{sl_prev=sl_cur;sl_cur=sl_next;sl_next=(sl_next==(NSLOT-1)*SLOTB)?0:sl_next+SLOTB;}while(0)
  DMA_K(2,2*SLOTB);
  WAIT_BAR(3);
  qkt(pA0,pA1,Kbase,qr,negm,r32,hi);asm volatile("s_nop 15\n\ts_nop 7":"+v"(pA0),"+v"(pA1));cmask(pA0,pA1,0,qrel,hi);
  START(pA0,pA1);
  _Pragma("unroll") for(int r=0;r<16;++r)pA1[r]=__builtin_amdgcn_exp2f(pA1[r]);
  WAIT_BAR(0);
  DMA_K(3,0);DMA_V(1,SLOTB);
  ROT();
  kload8(kf,kp0+sl_cur);
  WAIT_BAR(2);
  s16x4 vlo[8],vhi[8]; u32x4 pw0,pw1,pw2,pw3;
  #define PKW(P,B) cvtpk_s(P[B],P[B+1])
  #define PAF(k) __builtin_bit_cast(bf16x8,pw##k)
  #define VFR(i) (bf16x8){vlo[i][0],vlo[i][1],vlo[i][2],vlo[i][3],vhi[i][0],vhi[i][1],vhi[i][2],vhi[i][3]}
  #define PIN(x) asm volatile("":"+v"(x))
  #define MX3(a,b,c) __builtin_fmaxf(__builtin_fmaxf((a),(b)),(c))
  #define GAPA(MF,A0,A1,A2,A3,W0,W1,PW) do{ MF; sacc+=A0; sacc+=A1; sacc+=A2; sacc+=A3; PIN(sacc); W0; W1; PIN(PW); SBAR(); }while(0)
  #define EX(v) __builtin_amdgcn_exp2f(v)
  #define GAPB(MF,X,B) do{ MF; X[B]=EX(X[B]); X[B+1]=EX(X[B+1]); X[B+2]=EX(X[B+2]); X[B+3]=EX(X[B+3]); PIN(X); SBAR(); }while(0)
  #define VRD(i) do{ vlo[i]=vtr(vp_+(((i)>>2)*4096+((i)&3)*1024)); vhi[i]=vtr(vp_+(((i)>>2)*4096+((i)&3)*1024+512)); }while(0)
  #define KRD(G,j) do{ if(G){ kload2(kf,kp0+sl_next,j); SBAR(); } }while(0)
  #define STEP(C0,C1,P0,P1,t,GK,GV,GL) do{ SBAR(); \
    const lds_cptr vp_=vp0+sl_prev; \
    VRD(0); SBAR(); float sacc=(P0[0]+P0[1]); \
    GAPA(C0=__builtin_amdgcn_mfma_f32_32x32x16_bf16(kf[0],qr[0],negm,0,0,0), P0[2],P0[3],P0[4],P0[5],     pw0[0]=PKW(P0,0), pw0[1]=PKW(P0,2), pw0); \
    VRD(4); SBAR(); GAPA(C1=__builtin_amdgcn_mfma_f32_32x32x16_bf16(kf[1],qr[0],negm,0,0,0), P0[6],P0[7],P0[8],P0[9],     pw0[2]=PKW(P0,4), pw0[3]=PKW(P0,6), pw0); \
    VRD(1); SBAR(); GAPA(C0=__builtin_amdgcn_mfma_f32_32x32x16_bf16(kf[2],qr[1],C0,0,0,0),   P0[10],P0[11],P0[12],P0[13], pw1[0]=PKW(P0,8), pw1[1]=PKW(P0,10), pw1); \
    VRD(5); SBAR(); GAPA(C1=__builtin_amdgcn_mfma_f32_32x32x16_bf16(kf[3],qr[1],C1,0,0,0),   P0[14],P0[15],P1[0],P1[1],   pw1[2]=PKW(P0,12),pw1[3]=PKW(P0,14), pw1); \
    VRD(2); SBAR(); GAPA(C0=__builtin_amdgcn_mfma_f32_32x32x16_bf16(kf[4],qr[2],C0,0,0,0),   P1[2],P1[3],P1[4],P1[5],     pw2[0]=PKW(P1,0), pw2[1]=PKW(P1,2), pw2); \
    VRD(6); SBAR(); GAPA(C1=__builtin_amdgcn_mfma_f32_32x32x16_bf16(kf[5],qr[2],C1,0,0,0),   P1[6],P1[7],P1[8],P1[9],     pw2[2]=PKW(P1,4), pw2[3]=PKW(P1,6), pw2); \
    VRD(3); SBAR(); GAPA(C0=__builtin_amdgcn_mfma_f32_32x32x16_bf16(kf[6],qr[3],C0,0,0,0),   P1[10],P1[11],P1[12],P1[13], pw3[0]=PKW(P1,8), pw3[1]=PKW(P1,10), pw3); \
    VRD(7); SBAR(); GAPA(C1=__builtin_amdgcn_mfma_f32_32x32x16_bf16(kf[7],qr[3],C1,0,0,0),   P1[14],P1[15],0.f,0.f,       pw3[2]=PKW(P1,12),pw3[3]=PKW(P1,14), pw3); \
    l_reg+=sacc; \
    if(GK){DMA_K((t)+3,sl_cur);} if(GV){DMA_V((t)+1,sl_next);} \
    CMASK(C0,C1,t); \
    { float a=MX3(C0[0],C0[1],C1[0]),b=MX3(C0[2],C0[3],C1[1]); a=MX3(a,C1[2],C1[3]); \
      _Pragma("unroll") for(int r=4;r<16;r+=4){a=MX3(a,C0[r],C0[r+1]);b=MX3(b,C0[r+2],C0[r+3]);a=MX3(a,C1[r],C1[r+1]);b=MX3(b,C1[r+2],C1[r+3]);} \
      float rm=__builtin_fmaxf(a,b); { auto rr=__builtin_amdgcn_permlane32_swap(__float_as_uint(rm),__float_as_uint(rm),false,false); rm=__builtin_fmaxf(__uint_as_float(rr[0]),__uint_as_float(rr[1])); } \
      resc=false; \
      if(__builtin_expect(__any(rm>(float)THRL),0)){ const float dl=__builtin_fmaxf(rm,0.f); mhat+=dl; \
        _Pragma("unroll") for(int r=0;r<16;++r){C0[r]-=dl;C1[r]-=dl;} \
        _Pragma("unroll") for(int r=0;r<16;++r)negm[r]=-mhat; asm volatile("":"+v"(negm)); \
        const float f=__builtin_amdgcn_exp2f(-dl); l_reg*=f; if(hi==0)wsf[r32]=f; resc=true; } } \
    SBAR(); \
    GAPB(o[0]=__builtin_amdgcn_mfma_f32_32x32x16_bf16(PAF(0),VFR(0),o[0],0,0,0), C0,0); \
    GAPB(o[1]=__builtin_amdgcn_mfma_f32_32x32x16_bf16(PAF(0),VFR(4),o[1],0,0,0), C0,4); \
    KRD(GL,0); GAPB(o[0]=__builtin_amdgcn_mfma_f32_32x32x16_bf16(PAF(1),VFR(1),o[0],0,0,0), C0,8); \
    KRD(GL,1); GAPB(o[1]=__builtin_amdgcn_mfma_f32_32x32x16_bf16(PAF(1),VFR(5),o[1],0,0,0), C0,12); \
    KRD(GL,2); GAPB(o[0]=__builtin_amdgcn_mfma_f32_32x32x16_bf16(PAF(2),VFR(2),o[0],0,0,0), C1,0); \
    KRD(GL,3); GAPB(o[1]=__builtin_amdgcn_mfma_f32_32x32x16_bf16(PAF(2),VFR(6),o[1],0,0,0), C1,4); \
    GAPB(o[0]=__builtin_amdgcn_mfma_f32_32x32x16_bf16(PAF(3),VFR(3),o[0],0,0,0), C1,8); \
    GAPB(o[1]=__builtin_amdgcn_mfma_f32_32x32x16_bf16(PAF(3),VFR(7),o[1],0,0,0), C1,12); \
    }while(0)
  int t=1;
  #undef CMASK
  #define CMASK(P0,P1,t) do{ if((t)<4){cmask(P0,P1,(t),qrel,hi);} else { const float ad_=((selbits>>(((t)-4)>>2))&1u)?0.f:-INFINITY; _Pragma("unroll") for(int r_=0;r_<16;++r_){P0[r_]+=ad_;P1[r_]+=ad_;} } }while(0)
  for(;t+5<NT;t+=2){
    STEP(pB0,pB1,pA0,pA1,t,true,true,true);     WAIT_BAR(2); RESC(); ROT();
    STEP(pA0,pA1,pB0,pB1,t+1,true,true,true);   WAIT_BAR(2); RESC(); ROT();
  }
  #undef CMASK
  #define CMASK(P0,P1,t) do{ if((t)<4){cmask(P0,P1,(t),qrel,hi);} else { const float ad_=((selbits>>(((t)-4)>>2))&1u)?0.f:-INFINITY; _Pragma("unroll") for(int r_=0;r_<16;++r_){P0[r_]+=ad_;P1[r_]+=ad_;} } }while(0)
  #define ENDW(tt) do{ if((tt)+3<NT){WAIT_BAR(2);} else if((tt)+2<NT){WAIT_BAR(1);} else {WAIT_BAR(0);} }while(0)
  for(;t+1<NT;t+=2){
    STEP(pB0,pB1,pA0,pA1,t,(t+3<NT),(t+1<NT),(t+1<NT));       ENDW(t);   RESC(); ROT();
    STEP(pA0,pA1,pB0,pB1,t+1,(t+4<NT),(t+2<NT),(t+2<NT));     ENDW(t+1); RESC(); ROT();
  }
  STEP(pB0,pB1,pA0,pA1,NT-1,false,false,false); RESC();
  { float sacc=pB0[0]+pB0[1]; _Pragma("unroll") for(int r=2;r<16;++r)sacc+=pB0[r]; _Pragma("unroll") for(int r=0;r<16;++r)sacc+=pB1[r]; l_reg+=sacc;
    pw0=(u32x4){PKW(pB0,0),PKW(pB0,2),PKW(pB0,4),PKW(pB0,6)};pw1=(u32x4){PKW(pB0,8),PKW(pB0,10),PKW(pB0,12),PKW(pB0,14)};pw2=(u32x4){PKW(pB1,0),PKW(pB1,2),PKW(pB1,4),PKW(pB1,6)};pw3=(u32x4){PKW(pB1,8),PKW(pB1,10),PKW(pB1,12),PKW(pB1,14)};
    SBAR(); pv(o,vb0+sl_cur,PAF(0),PAF(1),PAF(2),PAF(3)); }
  #undef PKW
  #undef PAF
  #undef VFR
  #undef PIN
  #undef MX3
  #undef GAPA
  #undef GAPB
  #undef EX
  #undef VRD
  #undef KRD
  #undef STEP
  #undef ENDW
  {auto rr=__builtin_amdgcn_permlane32_swap(__float_as_uint(l_reg),__float_as_uint(l_reg),false,false);l_reg=__uint_as_float(rr[0])+__uint_as_float(rr[1]);}
  if(hi==0)wsf[32+r32]=l_reg;asm volatile("s_waitcnt lgkmcnt(0)":::"memory");
  float rli[16];
  #pragma unroll
  for(int r=0;r<16;++r)rli[r]=__builtin_amdgcn_rcpf(wsf[32+crow(r,hi)]);
  bf16*Ow=O+(rowbase+q0+wid*QBLK)*DM+h*D;
  { bf16*stg=(bf16*)(shm+LDS_OST)+wid*2048;
    #pragma unroll
    for(int r=0;r<16;++r){const int orow=crow(r,hi);
      #pragma unroll
      for(int d0=0;d0<2;++d0)stg[orow*64+d0*32+r32]=__float2bfloat16(o[d0][r]*rli[r]);}
    asm volatile("s_waitcnt lgkmcnt(0)":::"memory");
    #pragma unroll
    for(int i=0;i<4;++i){const int row=i*8+(lane>>3),ch=lane&7; const u32x4 v=*(const u32x4*)(stg+row*64+ch*8); ATTN_STORE16(Ow+(long)row*DM+ch*8,v);} }
  asm volatile("s_waitcnt lgkmcnt(0)\n\ts_barrier":::"memory");
  #undef DMA_K
  #undef KT
  #undef DMA_V
  #undef CMASK
  #undef START
  #undef RESC
  #undef ROT
}
constexpr int ATTN_LDS_BYTES=LDS_BYTES;
struct AttnTensors { const bf16* Q; const bf16* K; const bf16* V; bf16* O; const float* ksum; };
struct AttnUnit { int bh; int qb; };
struct StaticOrder {
  int vcu,G;
  __device__ __forceinline__ explicit StaticOrder(int grid,int block):vcu((grid%8==0)?(block%8)*(grid/8)+block/8:block),G(grid){}
  __device__ __forceinline__ bool next(int i,AttnUnit&u)const{ const int bh=vcu+(i>>3)*G; if(bh>=BATCH*NHEAD)return false; u.bh=bh; u.qb=i&7; return true; }
  __device__ __forceinline__ void a_ready(const AttnUnit&)const{}
  __device__ __forceinline__ void done(const AttnUnit&)const{}
};
template<class Sched,int THRL=8> __device__ __forceinline__ void attn_phase(char*lds,const AttnTensors&T,const Sched&S){
  AttnUnit u;
  for(int i=0;S.next(i,u);++i){ S.a_ready(u); attn_unit<THRL>(u.bh/NHEAD,u.bh%NHEAD,u.qb,T.Q,T.K,T.V,T.O,lds,T.ksum); S.done(u); }
}
#undef SBAR
#undef WAIT_BAR
}
namespace ret_body {
typedef unsigned short bf16;
typedef short bf16x8 __attribute__((ext_vector_type(8)));
typedef short s16x4 __attribute__((ext_vector_type(4)));
typedef float f32x4 __attribute__((ext_vector_type(4)));
typedef float f32x2 __attribute__((ext_vector_type(2)));
typedef __bf16 bf16x2_t __attribute__((ext_vector_type(2)));
typedef unsigned u32x4 __attribute__((ext_vector_type(4)));
typedef unsigned u32x2 __attribute__((ext_vector_type(2)));
#define RLAS __attribute__((address_space(3)))
constexpr int KS = 160, VS = 288, OS = 272;
constexpr int L_K = 0, L_V = 20480, L_ST = 57344, L_O = 77824, L_END = 112640;
__device__ __forceinline__ unsigned cvtpk(float lo, float hi) { f32x2 v = {lo, hi}; bf16x2_t b = __builtin_convertvector(v, bf16x2_t); return __builtin_bit_cast(unsigned, b); }
typedef short v4i16_t __attribute__((ext_vector_type(4)));
__device__ __forceinline__ s16x4 trr(RLAS unsigned char* p) { return __builtin_bit_cast(s16x4, __builtin_amdgcn_ds_read_tr16_b64_v4i16((RLAS v4i16_t*)p)); }
__device__ __forceinline__ float bfv(short x) { return __builtin_bit_cast(float, ((unsigned)(unsigned short)x) << 16); }

__device__ __forceinline__ void ret_unit(int b, int h, const bf16* RQ, const bf16* RK, const bf16* RV, bf16* RG, const float* gnw, RLAS unsigned char* lds) {
    int tid_ = threadIdx.x; asm volatile("" : "+v"(tid_));
    const int tid = tid_, lane = tid & 63, il = lane & 15, g = lane >> 4; const int w = __builtin_amdgcn_readfirstlane(tid >> 6);
    const float lg = log2f(1.0f - exp2f(-5.0f - (float)h));
#define GP(n) exp2f((float)(n) * lg)
    float baseO[4], baseD[4], xi[4], zb[8];
#pragma unroll
    for (int r = 0; r < 4; ++r) { const int e_ = il - 4 * g - r; baseO[r] = GP(e_); baseD[r] = (e_ >= 0) ? baseO[r] : 0.f; xi[r] = GP(16 * w + 4 * g + r + 1); }
#pragma unroll
    for (int jj = 0; jj < 8; ++jj) { const int jl = (jj < 4) ? 4 * g + jj : 16 + 4 * g + (jj - 4); zb[jj] = GP(31 - jl); }
    const float g128 = GP(128);
    float gn[8];
#pragma unroll
    for (int e = 0; e < 8; ++e) gn[e] = gnw[h * 128 + 8 * il + e];
    for (int o = tid * 8; o < 128 * KS; o += 512 * 8) *(RLAS u32x2*)(lds + L_ST + o) = (u32x2){0u, 0u};
    f32x4 Sacc[4];
#pragma unroll
    for (int q = 0; q < 4; ++q) Sacc[q] = (f32x4){0.f, 0.f, 0.f, 0.f};
    const size_t rowb = (size_t)b * 2048;
    u32x4 kreg[2], vreg[4];
#define RET_LOADKV(n_) do { const size_t r0_ = rowb + (size_t)(n_) * 128; \
        _Pragma("unroll") for (int u = 0; u < 2; ++u) { const int c = tid + 512 * u; kreg[u] = *(const u32x4*)(RK + (r0_ + (c >> 3)) * 512 + h * 64 + 8 * (c & 7)); } \
        _Pragma("unroll") for (int u = 0; u < 4; ++u) { const int c = tid + 512 * u; vreg[u] = *(const u32x4*)(RV + (r0_ + (c >> 4)) * 1024 + h * 128 + 8 * (c & 15)); } } while (0)
#define RET_STOREKV() do { \
        _Pragma("unroll") for (int u = 0; u < 2; ++u) { const int c = tid + 512 * u; *(RLAS u32x4*)(lds + L_K + (c >> 3) * KS + (c & 7) * 16) = kreg[u]; } \
        _Pragma("unroll") for (int u = 0; u < 4; ++u) { const int c = tid + 512 * u; *(RLAS u32x4*)(lds + L_V + (c >> 4) * VS + (c & 15) * 16) = vreg[u]; } } while (0)
    RET_LOADKV(0); RET_STOREKV();
    __syncthreads();
    const int db = w & 3, eq0 = 4 * (w >> 2);
#pragma unroll 1
    for (int n = 0; n < 16; ++n) {
        const size_t row0 = rowb + (size_t)n * 128;
        bf16x8 qf[2];
#pragma unroll
        for (int ks = 0; ks < 2; ++ks) qf[ks] = *(const bf16x8*)(RQ + (row0 + 16 * w + il) * 512 + h * 64 + 32 * ks + 8 * g);
        if (n + 1 < 16) RET_LOADKV(n + 1);
        unsigned pf[4][4];
#pragma unroll
        for (int m = 0; m < 4; ++m)
#pragma unroll
            for (int e = 0; e < 4; ++e) pf[m][e] = 0u;
#pragma unroll
        for (int jb = 0; jb < 8; ++jb) if (jb <= w) {
            f32x4 c = (f32x4){0.f, 0.f, 0.f, 0.f};
#pragma unroll
            for (int ks = 0; ks < 2; ++ks) { const bf16x8 a = *(const RLAS bf16x8*)(lds + L_K + (16 * jb + il) * KS + (32 * ks + 8 * g) * 2); c = __builtin_amdgcn_mfma_f32_16x16x32_bf16(a, qf[ks], c, 0, 0, 0); }
            float p[4];
            if (jb == w) {
#pragma unroll
                for (int r = 0; r < 4; ++r) p[r] = c[r] * baseD[r];
            } else { const float bfac = GP(16 * (w - jb));
#pragma unroll
                for (int r = 0; r < 4; ++r) p[r] = c[r] * (baseO[r] * bfac); }
            pf[jb >> 1][(jb & 1) * 2 + 0] = cvtpk(p[0], p[1]); pf[jb >> 1][(jb & 1) * 2 + 1] = cvtpk(p[2], p[3]);
        }
        f32x4 acc[8];
#pragma unroll
        for (int eb = 0; eb < 8; ++eb) { f32x4 c = (f32x4){0.f, 0.f, 0.f, 0.f};
#pragma unroll
            for (int ks = 0; ks < 2; ++ks) { const bf16x8 sb = *(const RLAS bf16x8*)(lds + L_ST + (16 * eb + il) * KS + (32 * ks + 8 * g) * 2); c = __builtin_amdgcn_mfma_f32_16x16x32_bf16(qf[ks], sb, c, 0, 0, 0); }
#pragma unroll
            for (int r = 0; r < 4; ++r) c[r] *= xi[r];
            acc[eb] = c; }
#pragma unroll
        for (int m = 0; m < 4; ++m) if (2 * m <= w) {
            const bf16x8 pa = __builtin_bit_cast(bf16x8, (u32x4){pf[m][0], pf[m][1], pf[m][2], pf[m][3]});
            RLAS unsigned char* vp = lds + L_V + (32 * m + 4 * g + (il >> 2)) * VS + (4 * (il & 3)) * 2;
#pragma unroll
            for (int eb = 0; eb < 8; ++eb) { const s16x4 v0 = trr(vp + eb * 32), v1 = trr(vp + eb * 32 + 16 * VS);
                const bf16x8 vb = (bf16x8){v0[0], v0[1], v0[2], v0[3], v1[0], v1[1], v1[2], v1[3]};
                acc[eb] = __builtin_amdgcn_mfma_f32_16x16x32_bf16(pa, vb, acc[eb], 0, 0, 0); }
        }
#pragma unroll
        for (int q = 0; q < 4; ++q) Sacc[q] = Sacc[q] * g128;
#pragma unroll
        for (int ks = 0; ks < 4; ++ks) {
            RLAS unsigned char* kp = lds + L_K + (32 * ks + 4 * g + (il >> 2)) * KS + (16 * db + 4 * (il & 3)) * 2;
            const s16x4 k0 = trr(kp), k1 = trr(kp + 16 * KS); const float zs = GP(96 - 32 * ks);
            u32x4 aw; aw.x = cvtpk(bfv(k0[0]) * (zb[0] * zs), bfv(k0[1]) * (zb[1] * zs)); aw.y = cvtpk(bfv(k0[2]) * (zb[2] * zs), bfv(k0[3]) * (zb[3] * zs));
            aw.z = cvtpk(bfv(k1[0]) * (zb[4] * zs), bfv(k1[1]) * (zb[5] * zs)); aw.w = cvtpk(bfv(k1[2]) * (zb[6] * zs), bfv(k1[3]) * (zb[7] * zs));
            const bf16x8 ka = __builtin_bit_cast(bf16x8, aw);
            RLAS unsigned char* vp = lds + L_V + (32 * ks + 4 * g + (il >> 2)) * VS + (4 * (il & 3)) * 2;
#pragma unroll
            for (int q = 0; q < 4; ++q) { const s16x4 v0 = trr(vp + (eq0 + q) * 32), v1 = trr(vp + (eq0 + q) * 32 + 16 * VS);
                const bf16x8 vb = (bf16x8){v0[0], v0[1], v0[2], v0[3], v1[0], v1[1], v1[2], v1[3]};
                Sacc[q] = __builtin_amdgcn_mfma_f32_16x16x32_bf16(ka, vb, Sacc[q], 0, 0, 0); }
        }
        RLAS unsigned char* ost = lds + L_O + w * (16 * OS);
#pragma unroll
        for (int r = 0; r < 4; ++r) {
            float s = 0.f;
#pragma unroll
            for (int eb = 0; eb < 8; ++eb) s += acc[eb][r];
            s += __shfl_xor(s, 1); s += __shfl_xor(s, 2); s += __shfl_xor(s, 4); s += __shfl_xor(s, 8);
            const float mu = s * (1.0f / 128.0f); float q2 = 0.f;
#pragma unroll
            for (int eb = 0; eb < 8; ++eb) { const float d = acc[eb][r] - mu; q2 += d * d; }
            q2 += __shfl_xor(q2, 1); q2 += __shfl_xor(q2, 2); q2 += __shfl_xor(q2, 4); q2 += __shfl_xor(q2, 8);
            const float rs = 1.0f / sqrtf(q2 * (1.0f / 128.0f) + 1e-6f);
#pragma unroll
            for (int eb = 0; eb < 8; ++eb) { const float y = (acc[eb][r] - mu) * rs; *(RLAS unsigned short*)(ost + (4 * g + r) * OS + (16 * eb + il) * 2) = (unsigned short)(cvtpk(y, 0.f) & 0xffffu); }
        }
        __syncthreads();
#pragma unroll
        for (int q = 0; q < 4; ++q) { u32x2 sw; sw.x = cvtpk(Sacc[q][0], Sacc[q][1]); sw.y = cvtpk(Sacc[q][2], Sacc[q][3]);
            *(RLAS u32x2*)(lds + L_ST + (16 * (eq0 + q) + il) * KS + (16 * db + 4 * g) * 2) = sw; }
        if (n + 1 < 16) RET_STOREKV();
#pragma unroll
        for (int k = 0; k < 4; ++k) { const int row = g + 4 * k;
            const u32x4 yw = *(const RLAS u32x4*)(ost + row * OS + il * 16);
            bf16* gp = RG + (row0 + 16 * w + row) * 1024 + h * 128 + 8 * il; const u32x4 gw = *(const u32x4*)gp;
            u32x4 ow;
            ow.x = cvtpk(__builtin_bit_cast(float, yw.x << 16) * gn[0] * __builtin_bit_cast(float, gw.x << 16), __builtin_bit_cast(float, yw.x & 0xffff0000u) * gn[1] * __builtin_bit_cast(float, gw.x & 0xffff0000u));
            ow.y = cvtpk(__builtin_bit_cast(float, yw.y << 16) * gn[2] * __builtin_bit_cast(float, gw.y << 16), __builtin_bit_cast(float, yw.y & 0xffff0000u) * gn[3] * __builtin_bit_cast(float, gw.y & 0xffff0000u));
            ow.z = cvtpk(__builtin_bit_cast(float, yw.z << 16) * gn[4] * __builtin_bit_cast(float, gw.z << 16), __builtin_bit_cast(float, yw.z & 0xffff0000u) * gn[5] * __builtin_bit_cast(float, gw.z & 0xffff0000u));
            ow.w = cvtpk(__builtin_bit_cast(float, yw.w << 16) * gn[6] * __builtin_bit_cast(float, gw.w << 16), __builtin_bit_cast(float, yw.w & 0xffff0000u) * gn[7] * __builtin_bit_cast(float, gw.w & 0xffff0000u));
            *(u32x4*)gp = ow; }
        __syncthreads();
    }
#undef GP
#undef RET_LOADKV
#undef RET_STOREKV
}
__device__ __forceinline__ void ret_phase(RLAS unsigned char* lds, const bf16* RQ, const bf16* RK, const bf16* RV, bf16* RG, const float* gnw, int vcu, int G) {
    for (int u = vcu; u < 32 * 8; u += G) { __syncthreads(); ret_unit(u >> 3, u & 7, RQ, RK, RV, RG, gnw, lds); }
}
#undef RLAS
}

#ifndef MK_N_LAUNCHES
#define MK_N_LAUNCHES 1
#endif
#ifndef FAST_ATTN
#define FAST_ATTN 1
#endif
#ifndef FAST_RET
#define FAST_RET 1
#endif
constexpr int N_PHASES = 9;
struct Args { const float* in[14]; float* out; unsigned char* ws; int ph_lo, ph_hi; };
__global__ void __launch_bounds__(NWAVES * 64, 2) fwd(Args args) {
    extern __shared__ __attribute__((aligned(16))) unsigned char lds[];
    Frame F;
    F.lds = (LAS unsigned char*)lds;
    F.MISC = (volatile LAS unsigned*)(F.lds + MISC_OFF);
    F.tid = threadIdx.x; F.lane = F.tid & 63; F.wave = __builtin_amdgcn_readfirstlane(F.tid >> 6);
    F.G = gridDim.x; { const int bx = blockIdx.x; F.vcu = (F.G % 8 == 0) ? (bx % 8) * (F.G / 8) + bx / 8 : bx; }
    Ptrs P;
    P.x = args.in[0]; P.c = args.in[1]; P.ln1w = args.in[2]; P.ln2w = args.in[3]; P.wada = args.in[4]; P.bada = args.in[5]; P.win = args.in[6]; P.gnw = args.in[7];
    P.wmo = args.in[8]; P.wro = args.in[9]; P.wout = args.in[10]; P.wff1 = args.in[11]; P.wff2 = args.in[12]; P.fnw = args.in[13]; P.out = args.out; P.ws = args.ws;
    unsigned char* ws = args.ws;
    for (int u = F.tid; u < (LDS_BYTES - LDSCTL_OFF) / 4; u += NWAVES * 64) ((LAS unsigned*)(F.lds + LDSCTL_OFF))[u] = 0u;
    __syncthreads();
    const int lo = args.ph_lo, hi = args.ph_hi;
    XcdBarrier bar; bar.bar = (unsigned*)(ws + WS_CTL) + CW_BAR; bar.x = 0; bar.st = nullptr;
    if (hi - lo > 1) bar = xcd_barrier_post((unsigned*)(ws + WS_CTL) + CW_BAR, F.MISC + 8);
#ifndef PH_MASK
#define PH_MASK 0x1ff
#endif
#define IN(k) (((PH_MASK >> (k)) & 1) && lo <= (k) && (k) < hi)
#define SEAM(k) do { if (IN(k) && IN((k) + 1)) xcd_barrier(bar); } while (0)
    typedef pg8::bf16_t pb;
    const float* ada = (const float*)(ws + WS_ADA);

    if (IN(0)) { phase0(F, P); SEAM(0); }
    if (IN(1)) { phase1(F, P); SEAM(1); }
    if (IN(2)) {
        pg8::Gemm g{(const pb*)(ws + WS_H), (const pb*)(ws + WS_WIN), M, NIN, D}; pg8::StaticOrder S; S.init(M, NIN, F.G, (int)blockIdx.x);
        pg8::EpiIn E{(pb*)(ws + WS_MQ), (pb*)(ws + WS_MK), (pb*)(ws + WS_MV), (pb*)(ws + WS_RQ), (pb*)(ws + WS_RK), (pb*)(ws + WS_RV), (pb*)(ws + WS_RG), (pb*)(ws + WS_SGA), (pb*)(ws + WS_SGR),
                     (const float*)(ws + WS_ROPE), (const float*)(ws + WS_ROPE) + 2048 * 64, (float*)(ws + WS_KSUM), QSCALE};
        pg8::gemm_phase<pg8::EpiIn, pg8::StaticOrder, true, true>(F.lds + RING_OFF, g, S, E);
        SEAM(2);
    }
    if (IN(3)) {
#if FAST_ATTN
        { const attn_body::AttnTensors AT{(const attn_body::bf16*)(ws + WS_MQ), (const attn_body::bf16*)(ws + WS_MK), (const attn_body::bf16*)(ws + WS_MV), (attn_body::bf16*)(ws + WS_MQ), (const float*)(ws + WS_KSUM)};
          const attn_body::StaticOrder S((int)F.G, (int)blockIdx.x);
          attn_body::attn_phase<attn_body::StaticOrder>((char*)lds + RING_OFF, AT, S); }
#else
        naive_moba(F, P);
#endif
#if FAST_RET
        ret_body::ret_phase(F.lds + RING_OFF, (const ret_body::bf16*)(ws + WS_RQ), (const ret_body::bf16*)(ws + WS_RK), (const ret_body::bf16*)(ws + WS_RV), (ret_body::bf16*)(ws + WS_RG), P.gnw, F.vcu, F.G);
#else
        naive_ret(F, P);
#endif
        SEAM(3);
    }
    if (IN(4)) {
        { pg8::Gemm g{(const pb*)(ws + WS_MQ), (const pb*)(ws + WS_WMO), M, D, 512}; pg8::StaticOrder S; S.init(M, D, F.G, (int)blockIdx.x);
          pg8::EpiMerge<false> E{(const pb*)(ws + WS_SGA), (pb*)(ws + WS_H)};
          pg8::gemm_phase<pg8::EpiMerge<false>, pg8::StaticOrder, true, true>(F.lds + RING_OFF, g, S, E); }
        { pg8::Gemm g{(const pb*)(ws + WS_RG), (const pb*)(ws + WS_WRO), M, D, D}; pg8::StaticOrder S; S.init(M, D, F.G, (int)blockIdx.x);
          pg8::EpiMerge<true> E{(const pb*)(ws + WS_SGR), (pb*)(ws + WS_H)};
          pg8::gemm_phase<pg8::EpiMerge<true>, pg8::StaticOrder, true, true>(F.lds + RING_OFF, g, S, E); }
        SEAM(4);
    }
    if (IN(5)) {
        pg8::Gemm g{(const pb*)(ws + WS_H), (const pb*)(ws + WS_WOUT), M, D, D}; pg8::StaticOrder S; S.init(M, D, F.G, (int)blockIdx.x);
        pg8::EpiRes E{P.x, P.out, ada + 2 * D, P.ln2w, ada + 4 * D, (pb*)(ws + WS_A2), (float*)(ws + WS_SS1)};
        pg8::gemm_phase<pg8::EpiRes, pg8::StaticOrder, true, true>(F.lds + RING_OFF, g, S, E);
        SEAM(5);
    }
    if (IN(6)) {
        pg8::Gemm g{(const pb*)(ws + WS_A2), (const pb*)(ws + WS_W1), M, FF, D}; pg8::StaticOrder S; S.init(M, FF, F.G, (int)blockIdx.x);
        pg8::EpiFF1 E{(pb*)(ws + WS_ACT), (const float*)(ws + WS_C1), (const float*)(ws + WS_SS1), EPSN};
        pg8::gemm_phase<pg8::EpiFF1, pg8::StaticOrder, true, true>(F.lds + RING_OFF, g, S, E);
        SEAM(6);
    }
    if (IN(7)) {
        pg8::Gemm g{(const pb*)(ws + WS_ACT), (const pb*)(ws + WS_W2), M, D, FF}; pg8::StaticOrder S; S.init(M, D, F.G, (int)blockIdx.x);
        pg8::EpiRes E{P.out, P.out, ada + 5 * D, nullptr, nullptr, nullptr, (float*)(ws + WS_SS2)};
        pg8::gemm_phase<pg8::EpiRes, pg8::StaticOrder, true, true>(F.lds + RING_OFF, g, S, E);
        SEAM(7);
    }
    if (IN(8)) { phase8(F, P); }
#undef IN
#undef SEAM
}

extern "C" void kernel_launch(void* const* d_in, const int* in_sizes, int n_in, void* d_out, int out_size, void* d_ws, size_t ws_size, hipStream_t stream) {
    static int grid = 0;
    if (grid == 0) {
        if (n_in != 14 || in_sizes[0] != M * D || out_size != M * D || ws_size < WS_END) { fprintf(stderr, "kernel_launch: shape/workspace mismatch: n_in %d in0 %d out %d ws %zu (need %zu)\n", n_in, n_in > 0 ? in_sizes[0] : -1, out_size, ws_size, (size_t)WS_END); grid = -1; return; }
        int dev = 0, cus = 0, per_cu = 0;
        if (hipGetDevice(&dev) != hipSuccess || hipDeviceGetAttribute(&cus, hipDeviceAttributeMultiprocessorCount, dev) != hipSuccess) { grid = -1; return; }
        if (hipFuncSetAttribute((const void*)fwd, hipFuncAttributeMaxDynamicSharedMemorySize, LDS_BYTES) != hipSuccess) { fprintf(stderr, "kernel_launch: hipFuncSetAttribute failed\n"); grid = -1; return; }
        if (hipOccupancyMaxActiveBlocksPerMultiprocessor(&per_cu, (const void*)fwd, NWAVES * 64, LDS_BYTES) != hipSuccess || per_cu < 1) { fprintf(stderr, "kernel_launch: occupancy query says %d blocks per CU\n", per_cu); }
        (void)hipGetLastError();
        grid = cus;
    }
    if (grid < 0) return;
    if (hipMemsetAsync((char*)d_ws + WS_CTL, 0, ZERO_BYTES, stream) != hipSuccess) { fprintf(stderr, "kernel_launch: memset failed\n"); return; }
    Args a{};
    for (int i = 0; i < 14; ++i) a.in[i] = (const float*)d_in[i];
    a.out = (float*)d_out; a.ws = (unsigned char*)d_ws;
    if (MK_N_LAUNCHES == 1) { a.ph_lo = 0; a.ph_hi = N_PHASES; hipLaunchKernelGGL(fwd, dim3(grid), dim3(NWAVES * 64), LDS_BYTES, stream, a); }
    else for (int li = 0; li < N_PHASES; ++li) { a.ph_lo = li; a.ph_hi = li + 1; hipLaunchKernelGGL(fwd, dim3(grid), dim3(NWAVES * 64), LDS_BYTES, stream, a); }
    const hipError_t le = hipPeekAtLastError();
    if (le != hipSuccess) fprintf(stderr, "kernel_launch: launch failed: %s\n", hipGetErrorName(le));
}
```
